# Optimizing an MI355X kernel written in HIP

```python
import math
import jax, jax.numpy as jnp
from jax import lax
import numpy as np

D_MODEL = 1024
BATCH = 8
SEQ = 4096
DEPTH = 2

FOX_WIDTH = D_MODEL // 2
FOX_HEADS = 8
FOX_HEAD_DIM = FOX_WIDTH // FOX_HEADS
S5_WIDTH = D_MODEL - FOX_WIDTH
S5_GROUP = 16
S5_GROUPS = S5_WIDTH // S5_GROUP
S5_STATE = 64
Q_BLOCK = 128
EVEN_IN = 3 * FOX_WIDTH + FOX_HEADS + S5_WIDTH
CONV_WIDTH = D_MODEL // 2
CONV_K = 3
RET_WIDTH = D_MODEL - CONV_WIDTH
RET_HEADS = 4
RET_HEAD_DIM = RET_WIDTH // RET_HEADS
RET_CHUNK = 128
ODD_IN = 3 * CONV_WIDTH + 4 * RET_WIDTH
D_FF = 4 * D_MODEL
EPS = 1e-6
N_EVEN = (DEPTH + 1) // 2
N_ODD = DEPTH // 2

kernel_name = "hybrid_fox_s5_shortconv_retention"

F32 = jnp.float32


def rms_norm(x, g):
    xf = x.astype(F32)
    y = xf * lax.rsqrt(jnp.mean(xf * xf, axis=-1, keepdims=True) + EPS)
    return (y * g.astype(F32)).astype(x.dtype)


def forgetting_attention(q, k, v, log_f):
    b, l, h, dh = q.shape
    nblk = l // Q_BLOCK
    c = jnp.cumsum(log_f.astype(F32), axis=1).transpose(0, 2, 1)
    scale = dh ** -0.5
    q_blocks = q.reshape(b, nblk, Q_BLOCK, h, dh).transpose(1, 0, 3, 2, 4)
    c_blocks = c.reshape(b, h, nblk, Q_BLOCK).transpose(2, 0, 1, 3)
    k_pos = jnp.arange(l)

    def block(args):
        i, q_i, cq_i = args
        s = jnp.einsum('bhqd,bkhd->bhqk', q_i, k).astype(F32) * scale
        s = s + cq_i[..., None] - c[:, :, None, :]
        q_pos = i * Q_BLOCK + jnp.arange(Q_BLOCK)
        causal = k_pos[None, :] <= q_pos[:, None]
        s = jnp.where(causal, s, -jnp.inf)
        p = jax.nn.softmax(s, axis=-1).astype(v.dtype)
        return jnp.einsum('bhqk,bkhd->bqhd', p, v)

    out = lax.map(block, (jnp.arange(nblk), q_blocks, c_blocks))
    return out.transpose(1, 0, 2, 3, 4).reshape(b, l, h * dh)


def s5_layer(u, log_dt, lam_re, lam_im, b_re, b_im, c_re, c_im, d_skip, w_glu, b_glu):
    b, l, _ = u.shape
    uf = u.astype(F32).reshape(b, l, S5_GROUPS, S5_GROUP)
    lam = lax.complex(lam_re.astype(F32), lam_im.astype(F32))
    dt = jnp.exp(log_dt.astype(F32))[:, None]
    lam_bar = jnp.exp(lam * dt)
    b_mat = lax.complex(b_re.astype(F32), b_im.astype(F32))
    b_bar = ((lam_bar - 1.0) / lam)[..., None] * b_mat
    c_mat = lax.complex(c_re.astype(F32), c_im.astype(F32))
    bu = jnp.einsum('blgh,gph->blgp', uf, b_bar)
    a = jnp.broadcast_to(lam_bar, (1, l, S5_GROUPS, S5_STATE))

    def combine(e1, e2):
        a1, b1 = e1
        a2, b2 = e2
        return a1 * a2, a2 * b1 + b2

    _, states = lax.associative_scan(combine, (a, bu), axis=1)
    y = jnp.real(jnp.einsum('blgp,ghp->blgh', states, c_mat))
    y = y + d_skip.astype(F32).reshape(S5_GROUPS, S5_GROUP) * uf
    y = jax.nn.gelu(y.reshape(b, l, S5_WIDTH))
    y = y * jax.nn.sigmoid(y @ w_glu.astype(F32) + b_glu.astype(F32))
    return y.astype(u.dtype)


def causal_depthwise_conv(x, w):
    ch = x.shape[-1]
    return lax.conv_general_dilated(
        x, w[:, None, :].astype(x.dtype), window_strides=(1,),
        padding=[(CONV_K - 1, 0)], dimension_numbers=('NWC', 'WIO', 'NWC'),
        feature_group_count=ch)


def rotate_every_two(x, pos):
    d = x.shape[-1]
    inv = 1.0 / (10000.0 ** jnp.linspace(0.0, 1.0, d // 2, dtype=F32))
    ang = pos.astype(F32)[:, None] * inv[None, :]
    cos = jnp.cos(ang)[None, :, None, :]
    sin = jnp.sin(ang)[None, :, None, :]
    x1, x2 = x[..., 0::2], x[..., 1::2]
    return jnp.stack([x1 * cos - x2 * sin, x1 * sin + x2 * cos], axis=-1).reshape(x.shape)


def retention_chunkwise(q, k, v):
    b, l, h, d = q.shape
    n = l // RET_CHUNK
    log_gamma = jnp.log(1.0 - 2.0 ** (-5.0 - jnp.arange(h, dtype=F32)))
    idx = jnp.arange(RET_CHUNK, dtype=F32)
    rel = idx[:, None] - idx[None, :]
    inner_decay = jnp.where(rel >= 0,
                            jnp.exp(log_gamma[:, None, None] * jnp.maximum(rel, 0.0)), 0.0)
    query_decay = jnp.exp(log_gamma[:, None] * (idx + 1.0))[None, :, :, None]
    key_decay = jnp.exp(log_gamma[:, None] * (RET_CHUNK - 1.0 - idx))[None, :, :, None]
    chunk_decay = jnp.exp(log_gamma * RET_CHUNK)[None, :, None, None]

    def to_chunks(t):
        return t.reshape(b, n, RET_CHUNK, h, t.shape[-1]).transpose(1, 0, 3, 2, 4)

    qc, kc, vc = to_chunks(q), to_chunks(k * d ** -0.5), to_chunks(v)

    def step(state, inp):
        q_i, k_i, v_i = inp
        s = jnp.einsum('bhqd,bhkd->bhqk', q_i, k_i) * inner_decay
        inner = jnp.einsum('bhqk,bhkv->bhqv', s, v_i)
        cross = jnp.einsum('bhqd,bhdv->bhqv', q_i, state) * query_decay
        new_state = state * chunk_decay + jnp.einsum('bhkd,bhkv->bhdv', k_i * key_decay, v_i)
        return new_state, inner + cross

    state0 = jnp.zeros((b, h, d, v.shape[-1]), F32)
    _, out = lax.scan(step, state0, (qc, kc, vc))
    return out.transpose(1, 0, 3, 2, 4).reshape(b, l, h, v.shape[-1])


def even_mixer(h, w_in, b_forget, log_dt, lam_re, lam_im, b_re, b_im, c_re, c_im,
               d_skip, w_glu, b_glu, w_out):
    b, l, _ = h.shape
    proj = h @ w_in
    q, k, v, f_logit, u = jnp.split(
        proj, [FOX_WIDTH, 2 * FOX_WIDTH, 3 * FOX_WIDTH, 3 * FOX_WIDTH + FOX_HEADS], axis=-1)
    heads = lambda t: t.reshape(b, l, FOX_HEADS, FOX_HEAD_DIM)
    log_f = jax.nn.log_sigmoid(f_logit.astype(F32) + b_forget.astype(F32))
    fox = forgetting_attention(heads(q), heads(k), heads(v), log_f)
    s5 = s5_layer(u, log_dt, lam_re, lam_im, b_re, b_im, c_re, c_im, d_skip, w_glu, b_glu)
    return jnp.concatenate([fox.astype(h.dtype), s5], axis=-1) @ w_out


def odd_mixer(h, w_in, conv_w, w_out):
    b, l, _ = h.shape
    proj = h @ w_in
    cw, rw = CONV_WIDTH, RET_WIDTH
    hc, gate_b, gate_c, q, k, v, g = jnp.split(
        proj, [cw, 2 * cw, 3 * cw, 3 * cw + rw, 3 * cw + 2 * rw, 3 * cw + 3 * rw], axis=-1)
    conv_out = gate_b * causal_depthwise_conv(gate_c * hc, conv_w)
    pos = jnp.arange(l)
    heads = lambda t: t.astype(F32).reshape(b, l, RET_HEADS, RET_HEAD_DIM)
    ret = retention_chunkwise(rotate_every_two(heads(q), pos), rotate_every_two(heads(k), pos), heads(v))
    mu = jnp.mean(ret, axis=-1, keepdims=True)
    var = jnp.mean(jnp.square(ret - mu), axis=-1, keepdims=True)
    ret = ((ret - mu) * lax.rsqrt(var + EPS)).reshape(b, l, rw)
    ret_out = (jax.nn.silu(g.astype(F32)) * ret).astype(h.dtype)
    return jnp.concatenate([conv_out, ret_out], axis=-1) @ w_out


def squared_relu_mlp(h, w_up, w_down):
    return jnp.square(jax.nn.relu(h @ w_up)) @ w_down


def setup_inputs(seed: int = 0) -> dict:
    key = jax.random.key(seed)
    ks = jax.random.split(key, 32)
    nrm = lambda k, shape, s: jax.random.normal(k, shape, F32) * s
    gain = lambda k, shape: 1.0 + 0.02 * jax.random.normal(k, shape, F32)
    x = jax.random.normal(ks[0], (BATCH, SEQ, D_MODEL), F32)
    lam_im_base = math.pi * jnp.arange(S5_STATE, dtype=F32)
    return {
        "x": x,
        "even_norm_mix": gain(ks[1], (N_EVEN, D_MODEL)),
        "even_w_in": nrm(ks[2], (N_EVEN, D_MODEL, EVEN_IN), D_MODEL ** -0.5),
        "even_b_forget": 3.0 + nrm(ks[3], (N_EVEN, FOX_HEADS), 0.1),
        "even_s5_log_dt": jax.random.uniform(ks[4], (N_EVEN, S5_GROUPS), F32,
                                              math.log(1e-3), math.log(1e-1)),
        "even_s5_lambda_re": -0.5 * jnp.exp(nrm(ks[5], (N_EVEN, S5_GROUPS, S5_STATE), 0.02)),
        "even_s5_lambda_im": lam_im_base + nrm(ks[6], (N_EVEN, S5_GROUPS, S5_STATE), 0.01),
        "even_s5_b_re": nrm(ks[7], (N_EVEN, S5_GROUPS, S5_STATE, S5_GROUP), (2 * S5_GROUP) ** -0.5),
        "even_s5_b_im": nrm(ks[8], (N_EVEN, S5_GROUPS, S5_STATE, S5_GROUP), (2 * S5_GROUP) ** -0.5),
        "even_s5_c_re": nrm(ks[9], (N_EVEN, S5_GROUPS, S5_GROUP, S5_STATE), (2 * S5_STATE) ** -0.5 * 4.0),
        "even_s5_c_im": nrm(ks[10], (N_EVEN, S5_GROUPS, S5_GROUP, S5_STATE), (2 * S5_STATE) ** -0.5 * 4.0),
        "even_s5_d": nrm(ks[11], (N_EVEN, S5_WIDTH), 1.0),
        "even_s5_w_glu": nrm(ks[12], (N_EVEN, S5_WIDTH, S5_WIDTH), S5_WIDTH ** -0.5),
        "even_s5_b_glu": nrm(ks[13], (N_EVEN, S5_WIDTH), 0.01),
        "even_w_out": nrm(ks[14], (N_EVEN, D_MODEL, D_MODEL), D_MODEL ** -0.5),
        "odd_norm_mix": gain(ks[15], (N_ODD, D_MODEL)),
        "odd_w_in": nrm(ks[16], (N_ODD, D_MODEL, ODD_IN), D_MODEL ** -0.5),
        "odd_conv_w": nrm(ks[17], (N_ODD, CONV_K, CONV_WIDTH), CONV_K ** -0.5),
        "odd_w_out": nrm(ks[18], (N_ODD, D_MODEL, D_MODEL), D_MODEL ** -0.5),
        "mlp_norm": gain(ks[19], (DEPTH, D_MODEL)),
        "mlp_w_up": nrm(ks[20], (DEPTH, D_MODEL, D_FF), D_MODEL ** -0.5),
        "mlp_w_down": nrm(ks[21], (DEPTH, D_FF, D_MODEL), D_FF ** -0.5),
        "final_norm": gain(ks[22], (D_MODEL,)),
    }


def reference(x, even_norm_mix, even_w_in, even_b_forget, even_s5_log_dt, even_s5_lambda_re,
              even_s5_lambda_im, even_s5_b_re, even_s5_b_im, even_s5_c_re, even_s5_c_im,
              even_s5_d, even_s5_w_glu, even_s5_b_glu, even_w_out, odd_norm_mix, odd_w_in,
              odd_conv_w, odd_w_out, mlp_norm, mlp_w_up, mlp_w_down, final_norm):
    for layer in range(DEPTH):
        j = layer // 2
        if layer % 2 == 0:
            x = x + even_mixer(rms_norm(x, even_norm_mix[j]), even_w_in[j], even_b_forget[j],
                               even_s5_log_dt[j], even_s5_lambda_re[j], even_s5_lambda_im[j],
                               even_s5_b_re[j], even_s5_b_im[j], even_s5_c_re[j], even_s5_c_im[j],
                               even_s5_d[j], even_s5_w_glu[j], even_s5_b_glu[j], even_w_out[j])
        else:
            x = x + odd_mixer(rms_norm(x, odd_norm_mix[j]), odd_w_in[j], odd_conv_w[j], odd_w_out[j])
        x = x + squared_relu_mlp(rms_norm(x, mlp_norm[layer]), mlp_w_up[layer], mlp_w_down[layer])
    return rms_norm(x, final_norm)
```

```cpp
#include <hip/hip_runtime.h>
#include <cstdio>
#include <cstdint>
#include <cmath>

namespace nv {
constexpr int B = 8, L = 4096, D = 1024, M = B * L;
constexpr int EVEN_IN = 2056, ODD_IN = 3584, DFF = 4096;
constexpr float EPS = 1e-6f;

__device__ __forceinline__ float wave_sum(float v) {
#pragma unroll
    for (int o = 1; o < 64; o <<= 1) v += __shfl_xor(v, o);
    return v;
}

__global__ void __launch_bounds__(256) k_rstd(const float* __restrict__ x, float* __restrict__ rstd, int rows, int pad) {
    const int w = (blockIdx.x * 256 + threadIdx.x) >> 6, lane = threadIdx.x & 63;
    if (w >= rows) return;
    const float4* xr = (const float4*)(x + (size_t)w * D) + lane;
    float s = 0.f;
#pragma unroll
    for (int j = 0; j < 4; ++j) { const float4 v = xr[64 * j]; s += v.x * v.x + v.y * v.y + v.z * v.z + v.w * v.w; }
    s = wave_sum(s);
    if (lane == 0) rstd[w] = 1.0f / sqrtf(s * (1.0f / D) + EPS);
}

__global__ void __launch_bounds__(256) k_final(const float* x, const float* __restrict__ g, float* out, int rows, int pad) {
    const int w = (blockIdx.x * 256 + threadIdx.x) >> 6, lane = threadIdx.x & 63;
    if (w >= rows) return;
    const float4* xr = (const float4*)(x + (size_t)w * D) + lane;
    float4 v[4]; float s = 0.f;
#pragma unroll
    for (int j = 0; j < 4; ++j) { v[j] = xr[64 * j]; s += v[j].x * v[j].x + v[j].y * v[j].y + v[j].z * v[j].z + v[j].w * v[j].w; }
    s = wave_sum(s);
    const float r = 1.0f / sqrtf(s * (1.0f / D) + EPS);
    float4* o = (float4*)(out + (size_t)w * D) + lane;
#pragma unroll
    for (int j = 0; j < 4; ++j) { const float4 gg = ((const float4*)g)[lane + 64 * j]; o[64 * j] = make_float4(v[j].x * r * gg.x, v[j].y * r * gg.y, v[j].z * r * gg.z, v[j].w * r * gg.w); }
}

struct EpiStore { float* C; int ldc; int pad; __device__ void operator()(int m, int n, float v) const { C[(size_t)m * ldc + n] = v; } };
struct EpiAddInto { float* C; int ldc; int pad; __device__ void operator()(int m, int n, float v) const { C[(size_t)m * ldc + n] += v; } };
struct EpiResid { const float* X; float* C; int ldc; int pad; __device__ void operator()(int m, int n, float v) const { C[(size_t)m * ldc + n] = X[(size_t)m * ldc + n] + v; } };
struct EpiRelu2 { float* C; int ldc; int pad; __device__ void operator()(int m, int n, float v) const { const float r = v > 0.f ? v : 0.f; C[(size_t)m * ldc + n] = r * r; } };
struct EpiGlu { const float* Y; const float* bias; float* C; int ldy; int ldc; int coff; int pad;
    __device__ void operator()(int m, int n, float v) const { const float y = Y[(size_t)m * ldy + n]; const float z = v + bias[n]; C[(size_t)m * ldc + coff + n] = y / (1.0f + expf(-z)); } };

template <class Epi>
__global__ void __launch_bounds__(256) k_gemm(const float* __restrict__ A, const float* __restrict__ rs, const float* __restrict__ gk,
                                              const float* __restrict__ W, int lda, int ldw, int K, int N, Epi epi) {
    __shared__ float As[16][68];
    __shared__ float Ws[16][68];
    const int tid = threadIdx.x, tx = tid & 15, ty = tid >> 4;
    const int m0 = blockIdx.y * 64, n0 = blockIdx.x * 64;
    float acc[4][4];
#pragma unroll
    for (int i = 0; i < 4; ++i)
#pragma unroll
        for (int j = 0; j < 4; ++j) acc[i][j] = 0.f;
    const int ar = tid >> 2, akq = (tid & 3) * 4;
    const int wk = tid >> 4, wn = (tid & 15) * 4;
    for (int k0 = 0; k0 < K; k0 += 16) {
        float4 a = *(const float4*)(A + (size_t)(m0 + ar) * lda + k0 + akq);
        if (gk) { const float4 g = *(const float4*)(gk + k0 + akq); a.x *= g.x; a.y *= g.y; a.z *= g.z; a.w *= g.w; }
        float4 w = make_float4(0.f, 0.f, 0.f, 0.f);
        if (n0 + wn < N) w = *(const float4*)(W + (size_t)(k0 + wk) * ldw + n0 + wn);
        __syncthreads();
        As[akq + 0][ar] = a.x; As[akq + 1][ar] = a.y; As[akq + 2][ar] = a.z; As[akq + 3][ar] = a.w;
        *(float4*)&Ws[wk][wn] = w;
        __syncthreads();
#pragma unroll
        for (int kk = 0; kk < 16; ++kk) {
            const float4 av = *(const float4*)&As[kk][ty * 4];
            const float4 bv = *(const float4*)&Ws[kk][tx * 4];
            const float aa[4] = {av.x, av.y, av.z, av.w}, bb[4] = {bv.x, bv.y, bv.z, bv.w};
#pragma unroll
            for (int i = 0; i < 4; ++i)
#pragma unroll
                for (int j = 0; j < 4; ++j) acc[i][j] = fmaf(aa[i], bb[j], acc[i][j]);
        }
    }
#pragma unroll
    for (int i = 0; i < 4; ++i) {
        const int m = m0 + ty * 4 + i; const float r = rs ? rs[m] : 1.0f;
#pragma unroll
        for (int j = 0; j < 4; ++j) { const int n = n0 + tx * 4 + j; if (n < N) epi(m, n, acc[i][j] * r); }
    }
}

__global__ void k_logf(const float* __restrict__ proj, const float* __restrict__ bf, float* __restrict__ logf) {
    const int i = blockIdx.x * 256 + threadIdx.x; if (i >= M * 8) return;
    const int m = i >> 3, h = i & 7;
    const float z = proj[(size_t)m * EVEN_IN + 1536 + h] + bf[h];
    const float r = (z > 0.f) ? -log1pf(expf(-z)) : (z - log1pf(expf(z)));
    logf[i] = r;
}
__global__ void __launch_bounds__(64) k_cumsum(const float* __restrict__ logf, float* __restrict__ c) {
    const int bh = blockIdx.x, b = bh >> 3, h = bh & 7, lane = threadIdx.x;
    float carry = 0.f;
    for (int l0 = 0; l0 < L; l0 += 64) {
        const size_t idx = ((size_t)(b * L + l0 + lane)) * 8 + h;
        float v = logf[idx];
#pragma unroll
        for (int o = 1; o < 64; o <<= 1) { const float t = __shfl_up(v, o); if (lane >= o) v += t; }
        v += carry;
        c[idx] = v;
        carry = __shfl(v, 63);
    }
}
__global__ void __launch_bounds__(128) k_fox(const float* __restrict__ proj, const float* __restrict__ c, float* __restrict__ mix) {
    __shared__ float Ks[32][64];
    __shared__ float Vs[32][64];
    __shared__ float Cs[32];
    const int qb = blockIdx.x, h = blockIdx.y, b = blockIdx.z, tid = threadIdx.x;
    const int t = qb * 128 + tid;
    const size_t rowq = (size_t)(b * L + t);
    float q[64], o[64];
#pragma unroll
    for (int d = 0; d < 64; d += 4) { const float4 v = *(const float4*)(proj + rowq * EVEN_IN + h * 64 + d); q[d] = v.x * 0.125f; q[d + 1] = v.y * 0.125f; q[d + 2] = v.z * 0.125f; q[d + 3] = v.w * 0.125f; }
#pragma unroll
    for (int d = 0; d < 64; ++d) o[d] = 0.f;
    const float ct = c[rowq * 8 + h];
    float mrun = -INFINITY, lrun = 0.f;
    const int ntile = (qb * 128 + 128) / 32;
    for (int kt = 0; kt < ntile; ++kt) {
        __syncthreads();
#pragma unroll
        for (int i = 0; i < 4; ++i) { const int f = tid + 128 * i, r = f >> 4, cq = (f & 15) * 4; const size_t rk = (size_t)(b * L + kt * 32 + r);
            *(float4*)&Ks[r][cq] = *(const float4*)(proj + rk * EVEN_IN + 512 + h * 64 + cq);
            *(float4*)&Vs[r][cq] = *(const float4*)(proj + rk * EVEN_IN + 1024 + h * 64 + cq); }
        if (tid < 32) Cs[tid] = c[((size_t)(b * L + kt * 32 + tid)) * 8 + h];
        __syncthreads();
        if (kt * 32 > t) continue;
        float s[32]; float tmax = -INFINITY;
#pragma unroll
        for (int j = 0; j < 32; ++j) {
            float a = 0.f;
#pragma unroll
            for (int d = 0; d < 64; d += 4) { const float4 kv = *(const float4*)&Ks[j][d]; a = fmaf(q[d], kv.x, a); a = fmaf(q[d + 1], kv.y, a); a = fmaf(q[d + 2], kv.z, a); a = fmaf(q[d + 3], kv.w, a); }
            a += ct - Cs[j];
            if (kt * 32 + j > t) a = -INFINITY;
            s[j] = a; tmax = fmaxf(tmax, a);
        }
        const float mnew = fmaxf(mrun, tmax);
        const float sc = expf(mrun - mnew);
        lrun *= sc;
#pragma unroll
        for (int d = 0; d < 64; ++d) o[d] *= sc;
        mrun = mnew;
#pragma unroll
        for (int j = 0; j < 32; ++j) {
            const float p = expf(s[j] - mnew); lrun += p;
#pragma unroll
            for (int d = 0; d < 64; d += 4) { const float4 vv = *(const float4*)&Vs[j][d]; o[d] = fmaf(p, vv.x, o[d]); o[d + 1] = fmaf(p, vv.y, o[d + 1]); o[d + 2] = fmaf(p, vv.z, o[d + 2]); o[d + 3] = fmaf(p, vv.w, o[d + 3]); }
        }
    }
    const float inv = 1.0f / lrun;
#pragma unroll
    for (int d = 0; d < 64; d += 4) *(float4*)(mix + rowq * D + h * 64 + d) = make_float4(o[d] * inv, o[d + 1] * inv, o[d + 2] * inv, o[d + 3] * inv);
}

__device__ __forceinline__ float gelu_tanh(float x) { const float u = 0.7978845608028654f * (x + 0.044715f * x * x * x); return 0.5f * x * (1.0f + tanhf(u)); }
__global__ void __launch_bounds__(64) k_s5(const float* __restrict__ proj, const float* __restrict__ log_dt, const float* __restrict__ lam_re, const float* __restrict__ lam_im,
                                           const float* __restrict__ b_re, const float* __restrict__ b_im, const float* __restrict__ c_re, const float* __restrict__ c_im,
                                           const float* __restrict__ d_skip, float* __restrict__ yg) {
    const int g = blockIdx.x, b = blockIdx.y, p = threadIdx.x;
    const float dt = expf(log_dt[g]);
    const float lr = lam_re[g * 64 + p], li = lam_im[g * 64 + p];
    const float er = expf(lr * dt); float sn, cs; sincosf(li * dt, &sn, &cs);
    const float lbr = er * cs, lbi = er * sn;
    const float nr = lbr - 1.0f, ni = lbi, den = lr * lr + li * li;
    const float cr = (nr * lr + ni * li) / den, ci = (ni * lr - nr * li) / den;
    float bbr[16], bbi[16], ccr[16], cci[16];
#pragma unroll
    for (int h = 0; h < 16; ++h) {
        const float br = b_re[(g * 64 + p) * 16 + h], bi = b_im[(g * 64 + p) * 16 + h];
        bbr[h] = cr * br - ci * bi; bbi[h] = cr * bi + ci * br;
        ccr[h] = c_re[(g * 16 + h) * 64 + p]; cci[h] = c_im[(g * 16 + h) * 64 + p];
    }
    const float dsk = (p < 16) ? d_skip[g * 16 + p] : 0.f;
    float xr = 0.f, xi = 0.f;
    for (int l = 0; l < L; ++l) {
        const size_t m = (size_t)(b * L + l);
        const float4* up = (const float4*)(proj + m * EVEN_IN + 1544 + g * 16);
        float u[16];
#pragma unroll
        for (int j = 0; j < 4; ++j) { const float4 v = up[j]; u[4 * j] = v.x; u[4 * j + 1] = v.y; u[4 * j + 2] = v.z; u[4 * j + 3] = v.w; }
        float bur = 0.f, bui = 0.f;
#pragma unroll
        for (int h = 0; h < 16; ++h) { bur = fmaf(u[h], bbr[h], bur); bui = fmaf(u[h], bbi[h], bui); }
        const float nxr = lbr * xr - lbi * xi + bur, nxi = lbr * xi + lbi * xr + bui;
        xr = nxr; xi = nxi;
        float yv = 0.f;
#pragma unroll
        for (int h = 0; h < 16; ++h) { const float t = wave_sum(ccr[h] * xr - cci[h] * xi); if (p == h) yv = t + dsk * u[h]; }
        if (p < 16) yg[m * 512 + g * 16 + p] = gelu_tanh(yv);
    }
}

__global__ void k_rot_table(float2* __restrict__ tab) {
    const int i = blockIdx.x * 256 + threadIdx.x; if (i >= L * 64) return;
    const int l = i >> 6, f = i & 63;
    const double inv = exp2(-(double)f / 63.0 * 13.287712379549449);
    const double ang = (double)l * inv;
    const double twopi = 6.283185307179586476925;
    double r = ang - twopi * rint(ang / twopi);
    const double hp = 1.5707963267948966192;
    const double kq = rint(r / hp); const double t = r - kq * hp;
    const double t2 = t * t;
    double sp = 1.0 / 6227020800.0; sp = sp * t2 - 1.0 / 39916800.0; sp = sp * t2 + 1.0 / 362880.0; sp = sp * t2 - 1.0 / 5040.0; sp = sp * t2 + 1.0 / 120.0; sp = sp * t2 - 1.0 / 6.0; sp = sp * t2 + 1.0; sp *= t;
    double cp = -1.0 / 87178291200.0; cp = cp * t2 + 1.0 / 479001600.0; cp = cp * t2 - 1.0 / 3628800.0; cp = cp * t2 + 1.0 / 40320.0; cp = cp * t2 - 1.0 / 720.0; cp = cp * t2 + 1.0 / 24.0; cp = cp * t2 - 0.5; cp = cp * t2 + 1.0;
    const int qd = ((int)kq) & 3;
    double s, c;
    if (qd == 0) { s = sp; c = cp; } else if (qd == 1) { s = cp; c = -sp; } else if (qd == 2) { s = -sp; c = -cp; } else { s = -cp; c = sp; }
    tab[i] = make_float2((float)c, (float)s);
}
__global__ void k_rotate(float* __restrict__ proj, const float2* __restrict__ tab, int rows, int pad) {
    const int i = blockIdx.x * 256 + threadIdx.x; if (i >= rows * 512) return;
    const int m = i >> 9, pr = i & 511, isk = pr >> 8, pp = pr & 255, f = pp & 63;
    const int l = m % L;
    float* x = proj + (size_t)m * ODD_IN + 1536 + isk * 512 + pp * 2;
    const float2 cs = tab[l * 64 + f];
    const float x1 = x[0], x2 = x[1];
    float o1 = x1 * cs.x - x2 * cs.y, o2 = x1 * cs.y + x2 * cs.x;
    if (isk) { o1 *= 0.08838834764831845f; o2 *= 0.08838834764831845f; }
    x[0] = o1; x[1] = o2;
}
__global__ void k_conv(const float* __restrict__ proj, const float* __restrict__ w, float* __restrict__ mix, int rows, int pad) {
    const int i = blockIdx.x * 256 + threadIdx.x; if (i >= rows * 512) return;
    const int m = i >> 9, c = i & 511, l = m % L;
    float y = 0.f;
#pragma unroll
    for (int j = 0; j < 3; ++j) { const int dl = 2 - j; if (l - dl >= 0) { const float* r = proj + (size_t)(m - dl) * ODD_IN; y = fmaf(w[j * 512 + c], r[1024 + c] * r[c], y); } }
    mix[(size_t)m * D + c] = proj[(size_t)m * ODD_IN + 512 + c] * y;
}
__global__ void __launch_bounds__(128) k_ret(const float* __restrict__ proj, float* __restrict__ mix) {
    __shared__ float Ks[32][128];
    __shared__ float Vs[32][128];
    const int qb = blockIdx.x, h = blockIdx.y, bl = blockIdx.z, tid = threadIdx.x;
    const int row = tid >> 1, half = tid & 1;
    const int t = qb * 64 + row;
    const size_t rowq = (size_t)(bl * L + t);
    const float lg = log2f(1.0f - exp2f(-5.0f - (float)h));
    float q[128], o[64];
#pragma unroll
    for (int d = 0; d < 128; d += 4) { const float4 v = *(const float4*)(proj + rowq * ODD_IN + 1536 + h * 128 + d); q[d] = v.x; q[d + 1] = v.y; q[d + 2] = v.z; q[d + 3] = v.w; }
#pragma unroll
    for (int d = 0; d < 64; ++d) o[d] = 0.f;
    const int ntile = (qb * 64 + 64) / 32;
    for (int kt = 0; kt < ntile; ++kt) {
        __syncthreads();
#pragma unroll
        for (int i = 0; i < 8; ++i) { const int f = tid + 128 * i, r = f >> 5, cq = (f & 31) * 4; const size_t rk = (size_t)(bl * L + kt * 32 + r);
            *(float4*)&Ks[r][cq] = *(const float4*)(proj + rk * ODD_IN + 2048 + h * 128 + cq);
            *(float4*)&Vs[r][cq] = *(const float4*)(proj + rk * ODD_IN + 2560 + h * 128 + cq); }
        __syncthreads();
        if (kt * 32 > t) continue;
        for (int j = 0; j < 32; ++j) {
            const int s = kt * 32 + j;
            if (s > t) break;
            float a = 0.f;
#pragma unroll
            for (int d = 0; d < 128; d += 4) { const float4 kv = *(const float4*)&Ks[j][d]; a = fmaf(q[d], kv.x, a); a = fmaf(q[d + 1], kv.y, a); a = fmaf(q[d + 2], kv.z, a); a = fmaf(q[d + 3], kv.w, a); }
            const float wgt = a * exp2f(lg * (float)(t - s));
#pragma unroll
            for (int d = 0; d < 64; d += 4) { const float4 vv = *(const float4*)&Vs[j][half * 64 + d]; o[d] = fmaf(wgt, vv.x, o[d]); o[d + 1] = fmaf(wgt, vv.y, o[d + 1]); o[d + 2] = fmaf(wgt, vv.z, o[d + 2]); o[d + 3] = fmaf(wgt, vv.w, o[d + 3]); }
        }
    }
#pragma unroll
    for (int d = 0; d < 64; d += 4) *(float4*)(mix + rowq * D + 512 + h * 128 + half * 64 + d) = make_float4(o[d], o[d + 1], o[d + 2], o[d + 3]);
}
__global__ void __launch_bounds__(256) k_gn_gate(const float* __restrict__ proj, float* __restrict__ mix, int rows, int pad) {
    const int w = (blockIdx.x * 256 + threadIdx.x) >> 6, lane = threadIdx.x & 63;
    if (w >= rows * 4) return;
    const int m = w >> 2, h = w & 3;
    float* r = mix + (size_t)m * D + 512 + h * 128 + lane * 2;
    const float a = r[0], b = r[1];
    const float mu = wave_sum(a + b) * (1.0f / 128.0f);
    const float da = a - mu, db = b - mu;
    const float var = wave_sum(da * da + db * db) * (1.0f / 128.0f);
    const float rs = 1.0f / sqrtf(var + EPS);
    const float* gp = proj + (size_t)m * ODD_IN + 3072 + h * 128 + lane * 2;
    const float g0 = gp[0], g1 = gp[1];
    r[0] = (g0 / (1.0f + expf(-g0))) * da * rs;
    r[1] = (g1 / (1.0f + expf(-g1))) * db * rs;
}
}

extern "C" void kernel_launch(void* const* d_in, const int* in_sizes, int n_in, void* d_out, int out_size, void* d_ws, size_t ws_size, hipStream_t stream) {
    using namespace nv;
    const size_t MiB = 1u << 20;
    if (n_in != 23 || out_size != M * D || ws_size < 512 * MiB) { fprintf(stderr, "kernel_launch: unexpected shapes n_in %d out %d ws %zu\n", n_in, out_size, ws_size); return; }
    const float* x = (const float*)d_in[0];
    const float* even_norm = (const float*)d_in[1]; const float* even_w_in = (const float*)d_in[2]; const float* even_bf = (const float*)d_in[3];
    const float* s5_log_dt = (const float*)d_in[4]; const float* s5_lre = (const float*)d_in[5]; const float* s5_lim = (const float*)d_in[6];
    const float* s5_bre = (const float*)d_in[7]; const float* s5_bim = (const float*)d_in[8]; const float* s5_cre = (const float*)d_in[9]; const float* s5_cim = (const float*)d_in[10];
    const float* s5_d = (const float*)d_in[11]; const float* s5_wglu = (const float*)d_in[12]; const float* s5_bglu = (const float*)d_in[13];
    const float* even_w_out = (const float*)d_in[14]; const float* odd_norm = (const float*)d_in[15]; const float* odd_w_in = (const float*)d_in[16];
    const float* odd_conv_w = (const float*)d_in[17]; const float* odd_w_out = (const float*)d_in[18]; const float* mlp_norm = (const float*)d_in[19];
    const float* mlp_w_up = (const float*)d_in[20]; const float* mlp_w_down = (const float*)d_in[21]; const float* final_norm = (const float*)d_in[22];
    float* out = (float*)d_out;
    char* ws = (char*)d_ws;
    float* proj0 = (float*)(ws);
    float* proj1 = (float*)(ws);
    float* Hq = (float*)(ws);
    float* mix = (float*)(ws + 264 * MiB);
    float* yg = (float*)(ws + 392 * MiB);
    float* rstd = (float*)(ws + 456 * MiB);
    float* logf_ = (float*)(ws + 458 * MiB);
    float* cbuf = (float*)(ws + 460 * MiB);
    float2* tab = (float2*)(ws + 462 * MiB);

    auto mlp = [&](int layer) {
        k_rstd<<<M / 4, 256, 0, stream>>>(out, rstd, M, 0);
        for (int qd = 0; qd < 4; ++qd) {
            const int r0 = qd * (M / 4);
            k_gemm<EpiRelu2><<<dim3(DFF / 64, (M / 4) / 64), 256, 0, stream>>>(out + (size_t)r0 * D, rstd + r0, mlp_norm + layer * D, mlp_w_up + (size_t)layer * D * DFF, D, DFF, D, DFF, EpiRelu2{Hq, DFF, 0});
            k_gemm<EpiAddInto><<<dim3(D / 64, (M / 4) / 64), 256, 0, stream>>>(Hq, nullptr, nullptr, mlp_w_down + (size_t)layer * DFF * D, DFF, D, DFF, D, EpiAddInto{out + (size_t)r0 * D, D, 0});
        }
    };

    k_rstd<<<M / 4, 256, 0, stream>>>(x, rstd, M, 0);
    k_gemm<EpiStore><<<dim3((EVEN_IN + 63) / 64, M / 64), 256, 0, stream>>>(x, rstd, even_norm, even_w_in, D, EVEN_IN, D, EVEN_IN, EpiStore{proj0, EVEN_IN, 0});
    k_logf<<<(M * 8 + 255) / 256, 256, 0, stream>>>(proj0, even_bf, logf_);
    k_cumsum<<<64, 64, 0, stream>>>(logf_, cbuf);
    k_fox<<<dim3(L / 128, 8, B), 128, 0, stream>>>(proj0, cbuf, mix);
    k_s5<<<dim3(32, B), 64, 0, stream>>>(proj0, s5_log_dt, s5_lre, s5_lim, s5_bre, s5_bim, s5_cre, s5_cim, s5_d, yg);
    k_gemm<EpiGlu><<<dim3(512 / 64, M / 64), 256, 0, stream>>>(yg, nullptr, nullptr, s5_wglu, 512, 512, 512, 512, EpiGlu{yg, s5_bglu, mix, 512, D, 512, 0});
    k_gemm<EpiResid><<<dim3(D / 64, M / 64), 256, 0, stream>>>(mix, nullptr, nullptr, even_w_out, D, D, D, D, EpiResid{x, out, D, 0});
    mlp(0);
    k_rot_table<<<(L * 64 + 255) / 256, 256, 0, stream>>>(tab);
    k_rstd<<<M / 4, 256, 0, stream>>>(out, rstd, M, 0);
    for (int hb = 0; hb < 2; ++hb) {
        const int r0 = hb * (M / 2), rows = M / 2;
        float* mixh = mix + (size_t)r0 * D;
        k_gemm<EpiStore><<<dim3(ODD_IN / 64, rows / 64), 256, 0, stream>>>(out + (size_t)r0 * D, rstd + r0, odd_norm, odd_w_in, D, ODD_IN, D, ODD_IN, EpiStore{proj1, ODD_IN, 0});
        k_conv<<<(rows * 512 + 255) / 256, 256, 0, stream>>>(proj1, odd_conv_w, mixh, rows, 0);
        k_rotate<<<(rows * 512 + 255) / 256, 256, 0, stream>>>(proj1, tab, rows, 0);
        k_ret<<<dim3(L / 64, 4, B / 2), 128, 0, stream>>>(proj1, mixh);
        k_gn_gate<<<(rows * 4 * 64 + 255) / 256, 256, 0, stream>>>(proj1, mixh, rows, 0);
        k_gemm<EpiAddInto><<<dim3(D / 64, rows / 64), 256, 0, stream>>>(mixh, nullptr, nullptr, odd_w_out, D, D, D, D, EpiAddInto{out + (size_t)r0 * D, D, 0});
    }
    mlp(1);
    k_final<<<M / 4, 256, 0, stream>>>(out, final_norm, out, M, 0);
}
```

```cpp
#include <hip/hip_runtime.h>
#include <hip/hip_bf16.h>
#include <cstdio>
#include <cstdint>
#include <cmath>
namespace pg8 {
#define PG8_LAS __attribute__((address_space(3)))
typedef unsigned short bf16_t;
typedef short bf16x8 __attribute__((ext_vector_type(8)));
typedef float f32x4 __attribute__((ext_vector_type(4)));
typedef unsigned u32x4 __attribute__((ext_vector_type(4)));
constexpr int BM = 256, BK = 64, HALF = 128, HTB = HALF * BK * 2  , STAGE_BYTES = 8 * HTB, NXCD = 8, WGM = 8;

__host__ __device__ __forceinline__ int lds_byte(int r, int c) { const int st = (r >> 4) * 2 + (c >> 5), rr = r & 15, cc = c & 31, ob = rr * 64 + cc * 2; return st * 1024 + (ob ^ (((ob >> 9) & 1) << 5)); }
__host__ __device__ __forceinline__ void stage_rc(int b, int& R, int& C) { const int st = b / 1024, sb = b % 1024, swz = sb ^ (((sb >> 9) & 1) << 5); R = (st >> 1) * 16 + swz / 64; C = (st & 1) * 32 + (swz % 64) / 2; }
__host__ __device__ __forceinline__ int perm32(int rho) { const int n = rho >> 4, i = rho & 15; return 8 * (i >> 2) + 4 * n + (i & 3); }

struct Unit { int pm, pn; };
struct Gemm { const bf16_t* A; const bf16_t* Bt; int M, N, K; };

struct StaticOrder {
    int nM, nN, nwg, G, c;
    __host__ __device__ void init(int M, int N, int G_, int c_) { nM = M / BM; nN = N / BM; nwg = nM * nN; G = G_; c = c_; }
    __host__ __device__ bool next(int i, Unit& u) const {
        const long L = (long)i * G + c; if (L >= nwg) return false;
        int wgid = (int)L; { const int q = nwg / NXCD, r = nwg % NXCD, xcd = wgid % NXCD, off = wgid / NXCD; wgid = (xcd < r ? xcd * (q + 1) : r * (q + 1) + (xcd - r) * q) + off; }
        const int nig = WGM * nN, gid = wgid / nig, fm = gid * WGM, gsz = (nM - fm) < WGM ? (nM - fm) : WGM;
        u.pm = fm + ((wgid % nig) % gsz); u.pn = (wgid % nig) / gsz; return true;
    }
    __device__ __forceinline__ void a_ready(const Unit&) const {}
    __device__ __forceinline__ void done(const Unit&) const {}
};

__device__ __forceinline__ unsigned cvt_pk_bf16(float lo, float hi) { unsigned r; asm volatile("v_cvt_pk_bf16_f32 %0, %1, %2" : "=v"(r) : "v"(lo), "v"(hi)); return r; }
typedef float f32x2 __attribute__((ext_vector_type(2)));
typedef unsigned u32x2 __attribute__((ext_vector_type(2)));
constexpr float RMS_EPS = 1e-6f;
__device__ __forceinline__ float row_rstd(const float* ssp, int nparts, int row) {
    const float* p = ssp + (size_t)row * 16; float s;
    if (nparts == 1) s = p[0];
    else { const f32x4 a = *(const f32x4*)p, b = *(const f32x4*)(p + 4), c = *(const f32x4*)(p + 8), d = *(const f32x4*)(p + 12);
        s = ((a[0] + a[1]) + (a[2] + a[3])) + ((b[0] + b[1]) + (b[2] + b[3])) + ((c[0] + c[1]) + (c[2] + c[3])) + ((d[0] + d[1]) + (d[2] + d[3])); }
    return 1.0f / sqrtf(s * (1.0f / 1024.0f) + RMS_EPS);
}
template <int ACT  , bool ROT>
struct EpiRsBf16 {
    static constexpr bool PERM = true, AFTER_DRAIN = false;
    bf16_t* O; int ldc; int tps; size_t split_stride; const float* ssp; int nparts; const float* rot; int rot_lo, rot_hi;
    __device__ __forceinline__ void operator()(const f32x4 (&acc)[2][2][4][2], const Unit& u, int wr, int wc, int fr, int fq) const {
        const int row0 = u.pm * BM + wr * 64 + fr;
        int colt = u.pn * BM; bf16_t* base = O;
        if (tps) { const int t = u.pn / tps; base += (size_t)t * split_stride; colt = (u.pn - t * tps) * BM; }
        const int col0 = colt + wc * 32 + 8 * fq;
        const bool dorot = ROT && (u.pn >= rot_lo) && (u.pn < rot_hi);
#pragma unroll
        for (int ai = 0; ai < 2; ++ai)
#pragma unroll
            for (int m = 0; m < 4; ++m) {
                const int row = row0 + ai * HALF + m * 16;
                const float rs = row_rstd(ssp, nparts, row);
                bf16_t* rowp = base + (size_t)row * ldc + col0;
                f32x4 c01 = {1.f, 0.f, 1.f, 0.f}, c23 = {1.f, 0.f, 1.f, 0.f};
                if (ROT) { if (dorot) { const float* tp = rot + ((size_t)(row & 4095) * 64 + wc * 16 + 4 * fq) * 2; c01 = *(const f32x4*)tp; c23 = *(const f32x4*)(tp + 4); } }
#pragma unroll
                for (int bj = 0; bj < 2; ++bj) {
                    f32x4 v0 = acc[ai][bj][m][0] * rs, v1 = acc[ai][bj][m][1] * rs;
                    if (ACT == 1) {
#pragma unroll
                        for (int j = 0; j < 4; ++j) { const float a = v0[j] > 0.f ? v0[j] : 0.f, b = v1[j] > 0.f ? v1[j] : 0.f; v0[j] = a * a; v1[j] = b * b; }
                    }
                    if (ROT) {
                        const f32x4 a0 = v0, a1 = v1;
                        v0[0] = a0[0] * c01[0] - a0[1] * c01[1]; v0[1] = a0[0] * c01[1] + a0[1] * c01[0];
                        v0[2] = a0[2] * c01[2] - a0[3] * c01[3]; v0[3] = a0[2] * c01[3] + a0[3] * c01[2];
                        v1[0] = a1[0] * c23[0] - a1[1] * c23[1]; v1[1] = a1[0] * c23[1] + a1[1] * c23[0];
                        v1[2] = a1[2] * c23[2] - a1[3] * c23[3]; v1[3] = a1[2] * c23[3] + a1[3] * c23[2];
                    }
                    u32x4 w; w.x = cvt_pk_bf16(v0[0], v0[1]); w.y = cvt_pk_bf16(v0[2], v0[3]); w.z = cvt_pk_bf16(v1[0], v1[1]); w.w = cvt_pk_bf16(v1[2], v1[3]);
                    *(u32x4*)(rowp + bj * HALF) = w;
                }
            }
    }
};
template <bool WRITE_XB>
struct EpiResid {
    static constexpr bool PERM = false, AFTER_DRAIN = false;
    const float* resid; float* out; bf16_t* xb; float* ssp; int ldc;
    __device__ __forceinline__ void operator()(const f32x4 (&acc)[2][2][4][2], const Unit& u, int wr, int wc, int fr, int fq) const {
        const int col0 = u.pn * BM + wc * 32 + 4 * fq;
#pragma unroll
        for (int ai = 0; ai < 2; ++ai)
#pragma unroll
            for (int m = 0; m < 4; ++m) {
                const int row = u.pm * BM + ai * HALF + wr * 64 + m * 16 + fr; const size_t off = (size_t)row * ldc + col0; float ss = 0.f;
#pragma unroll
                for (int bj = 0; bj < 2; ++bj)
#pragma unroll
                    for (int n = 0; n < 2; ++n) {
                        const f32x4 r = *(const f32x4*)(resid + off + bj * HALF + n * 16); const f32x4 o = r + acc[ai][bj][m][n];
                        *(f32x4*)(out + off + bj * HALF + n * 16) = o;
                        ss += (o[0] * o[0] + o[1] * o[1]) + (o[2] * o[2] + o[3] * o[3]);
                        if (WRITE_XB) { u32x2 w; w.x = cvt_pk_bf16(o[0], o[1]); w.y = cvt_pk_bf16(o[2], o[3]); *(u32x2*)(xb + off + bj * HALF + n * 16) = w; }
                    }
                ss += __shfl_xor(ss, 16); ss += __shfl_xor(ss, 32);
                if (fq == 0) ssp[(size_t)row * 16 + u.pn * 4 + wc] = ss;
                asm volatile("" ::: "memory");
            }
    }
};
struct EpiGlu {
    static constexpr bool PERM = true, AFTER_DRAIN = false;
    const bf16_t* Y; int ldy; const float* bias; bf16_t* O; int ldo; int ocol0;
    __device__ __forceinline__ void operator()(const f32x4 (&acc)[2][2][4][2], const Unit& u, int wr, int wc, int fr, int fq) const {
        const int row0 = u.pm * BM + wr * 64 + fr, col0 = u.pn * BM + wc * 32 + 8 * fq;
#pragma unroll
        for (int bj = 0; bj < 2; ++bj) {
            const f32x4 b0 = *(const f32x4*)(bias + col0 + bj * HALF), b1 = *(const f32x4*)(bias + col0 + bj * HALF + 4);
#pragma unroll
            for (int ai = 0; ai < 2; ++ai)
#pragma unroll
                for (int m = 0; m < 4; ++m) {
                    const int row = row0 + ai * HALF + m * 16;
                    const u32x4 yw = *(const u32x4*)(Y + (size_t)row * ldy + col0 + bj * HALF);
                    const f32x4 z0 = acc[ai][bj][m][0] + b0, z1 = acc[ai][bj][m][1] + b1;
                    float y[8], o[8];
                    y[0] = __uint_as_float(yw.x << 16); y[1] = __uint_as_float(yw.x & 0xffff0000u); y[2] = __uint_as_float(yw.y << 16); y[3] = __uint_as_float(yw.y & 0xffff0000u);
                    y[4] = __uint_as_float(yw.z << 16); y[5] = __uint_as_float(yw.z & 0xffff0000u); y[6] = __uint_as_float(yw.w << 16); y[7] = __uint_as_float(yw.w & 0xffff0000u);
#pragma unroll
                    for (int j = 0; j < 4; ++j) { o[j] = y[j] / (1.0f + __expf(-z0[j])); o[4 + j] = y[4 + j] / (1.0f + __expf(-z1[j])); }
                    u32x4 w; w.x = cvt_pk_bf16(o[0], o[1]); w.y = cvt_pk_bf16(o[2], o[3]); w.z = cvt_pk_bf16(o[4], o[5]); w.w = cvt_pk_bf16(o[6], o[7]);
                    *(u32x4*)(O + (size_t)row * ldo + ocol0 + col0 + bj * HALF) = w;
                }
        }
    }
};

template <class Epi, class Sched, bool ALIGN_EPI = false, bool SP2 = false>
__device__ __forceinline__ void gemm_phase(PG8_LAS unsigned char* lds, const Gemm g, const Sched& S, const Epi& E) {
    const int tid = threadIdx.x, wid = __builtin_amdgcn_readfirstlane(tid >> 6), lane = tid & 63, wr = wid >> 2, wc = wid & 3, fr = lane & 15, fq = lane >> 4;
    const int K = g.K, nt = K / BK;
    unsigned voffA[2], voffB[2];
#pragma unroll
    for (int i = 0; i < 2; ++i) { int R, C; stage_rc(tid * 16 + i * 8192, R, C); const int Rb = Epi::PERM ? ((R & ~31) + perm32(R & 31)) : R;
        voffA[i] = (unsigned)(R * K + C) * 2u; voffB[i] = (unsigned)(Rb * K + C) * 2u; }
    const size_t kstep = (size_t)(BK * 2);
    const size_t hstep = (size_t)HALF * K * 2;
    const size_t tstep = 2 * hstep;
    const unsigned ldsw = (unsigned)wid * 1024u;
    const int aoff = lds_byte(wr * 64 + fr, fq * 8), boff = lds_byte(wc * 32 + fr, fq * 8);
#define PG8_SA(b, h) (((b) * 2 + (h)) * HTB)
#define PG8_SB(b, h) ((4 + (b) * 2 + (h)) * HTB)
#define PG8_STAGE(bufoff, gbase, voff) do { _Pragma("unroll") for (int _i = 0; _i < 2; ++_i) \
        __builtin_amdgcn_global_load_lds((const unsigned*)((const char*)(gbase) + (voff)[_i]), (PG8_LAS unsigned*)(lds + (bufoff) + ldsw + _i * 8192), 16, 0, 0); } while (0)
#define PG8_LDA(dst, b, h) do { _Pragma("unroll") for (int m = 0; m < 4; ++m) _Pragma("unroll") for (int k = 0; k < 2; ++k) dst[m][k] = *(const PG8_LAS bf16x8*)(lds + PG8_SA(b, h) + aoff + m * 2048 + k * 1024); } while (0)
#define PG8_LDB(dst, b, h) do { _Pragma("unroll") for (int n = 0; n < 2; ++n) _Pragma("unroll") for (int k = 0; k < 2; ++k) dst[n][k] = *(const PG8_LAS bf16x8*)(lds + PG8_SB(b, h) + boff + n * 2048 + k * 1024); } while (0)
#define PG8_MMA(ai, bj, At, Bt) do { __builtin_amdgcn_s_setprio(1); _Pragma("unroll") for (int m = 0; m < 4; ++m) _Pragma("unroll") for (int n = 0; n < 2; ++n) _Pragma("unroll") for (int k = 0; k < 2; ++k) \
        acc[ai][bj][m][n] = __builtin_amdgcn_mfma_f32_16x16x32_bf16(Bt[n][k], At[m][k], acc[ai][bj][m][n], 0, 0, 0); __builtin_amdgcn_s_setprio(0); } while (0)
#define PG8_WAIT_V(n) asm volatile("s_waitcnt vmcnt(" #n ")" ::: "memory")
#define PG8_WAIT_L(n) asm volatile("s_waitcnt lgkmcnt(" #n ")" ::: "memory")
#define PG8_BAR __builtin_amdgcn_s_barrier()
#define PG8_SCHED __builtin_amdgcn_sched_barrier(0)
    Unit cur, nxt; int ui = 0;
    if (!S.next(0, cur)) return;
    f32x4 acc[2][2][4][2];
#pragma unroll
    for (int a = 0; a < 2; ++a)
#pragma unroll
        for (int b = 0; b < 2; ++b)
#pragma unroll
            for (int m = 0; m < 4; ++m)
#pragma unroll
                for (int n = 0; n < 2; ++n) acc[a][b][m][n] = (f32x4){0.f, 0.f, 0.f, 0.f};
    bf16x8 At[4][2], B0[2][2], B1[2][2];
    const char* cA = (const char*)g.A + (size_t)cur.pm * tstep; const char* cB = (const char*)g.Bt + (size_t)cur.pn * tstep;
    S.a_ready(cur);
    if constexpr (SP2) {
        PG8_STAGE(PG8_SB(0, 0), cB, voffB); PG8_STAGE(PG8_SB(0, 1), cB + hstep, voffB); PG8_STAGE(PG8_SA(0, 0), cA, voffA); PG8_STAGE(PG8_SA(0, 1), cA + hstep, voffA);
        if (wr == 1) PG8_BAR;
        PG8_WAIT_V(2); PG8_BAR;
        PG8_STAGE(PG8_SB(1, 0), cB + kstep, voffB); PG8_STAGE(PG8_SA(1, 0), cA + kstep, voffA); PG8_STAGE(PG8_SB(1, 1), cB + hstep + kstep, voffB);
        PG8_WAIT_V(6); PG8_BAR;
    } else {
        PG8_STAGE(PG8_SB(0, 0), cB, voffB); PG8_STAGE(PG8_SA(0, 0), cA, voffA); PG8_STAGE(PG8_SB(0, 1), cB + hstep, voffB); PG8_STAGE(PG8_SA(0, 1), cA + hstep, voffA);
        if (wr == 1) PG8_BAR;
        PG8_WAIT_V(4); PG8_BAR;
        PG8_STAGE(PG8_SB(1, 0), cB + kstep, voffB); PG8_STAGE(PG8_SA(1, 0), cA + kstep, voffA); PG8_STAGE(PG8_SB(1, 1), cB + hstep + kstep, voffB);
        PG8_WAIT_V(6); PG8_BAR;
    }
    for (;;) {
        const bool has_next = S.next(ui + 1, nxt);
        const char* nA = has_next ? (const char*)g.A + (size_t)nxt.pm * tstep : cA; const char* nB = has_next ? (const char*)g.Bt + (size_t)nxt.pn * tstep : cB;
        for (int t = 0; t < nt; t += 2) {
            const bool last = (t == nt - 2);
            const char* a1 = cA + (size_t)(t + 1) * kstep;
            const char* a2 = last ? nA : cA + (size_t)(t + 2) * kstep; const char* b2 = last ? nB : cB + (size_t)(t + 2) * kstep;
            const char* a3 = a2 + kstep; const char* b3 = b2 + kstep;
            if (last && has_next) S.a_ready(nxt);
            if constexpr (SP2) {
            PG8_LDB(B0, 0, 0); PG8_LDB(B1, 0, 1); PG8_SCHED; PG8_LDA(At, 0, 0); PG8_STAGE(PG8_SA(1, 1), a1 + hstep, voffA);
            PG8_WAIT_V(8); PG8_WAIT_L(0); PG8_BAR; PG8_MMA(0, 0, At, B0); PG8_MMA(0, 1, At, B1); PG8_BAR; PG8_SCHED;
            PG8_LDA(At, 0, 1); PG8_STAGE(PG8_SB(0, 0), b2, voffB); PG8_STAGE(PG8_SB(0, 1), b2 + hstep, voffB); PG8_STAGE(PG8_SA(0, 0), a2, voffA);
            PG8_WAIT_V(8); PG8_WAIT_L(0); PG8_BAR; PG8_MMA(1, 0, At, B0); PG8_MMA(1, 1, At, B1); PG8_BAR; PG8_SCHED;
            PG8_LDB(B0, 1, 0); PG8_LDB(B1, 1, 1); PG8_SCHED; PG8_LDA(At, 1, 0); PG8_STAGE(PG8_SA(0, 1), a2 + hstep, voffA);
            PG8_WAIT_V(8); PG8_WAIT_L(0); PG8_BAR; PG8_MMA(0, 0, At, B0); PG8_MMA(0, 1, At, B1); PG8_BAR; PG8_SCHED;
            PG8_LDA(At, 1, 1); PG8_STAGE(PG8_SB(1, 0), b3, voffB); PG8_STAGE(PG8_SB(1, 1), b3 + hstep, voffB); PG8_STAGE(PG8_SA(1, 0), a3, voffA);
            PG8_WAIT_V(8); PG8_WAIT_L(0); PG8_BAR; PG8_MMA(1, 0, At, B0); PG8_MMA(1, 1, At, B1); PG8_BAR; PG8_SCHED;
            } else {
            PG8_LDB(B0, 0, 0); PG8_SCHED; PG8_LDA(At, 0, 0); PG8_STAGE(PG8_SA(1, 1), a1 + hstep, voffA);
            PG8_WAIT_L(8); PG8_BAR; PG8_WAIT_L(0); PG8_MMA(0, 0, At, B0); PG8_BAR; PG8_SCHED;
            PG8_LDB(B1, 0, 1); PG8_STAGE(PG8_SB(0, 0), b2, voffB);
            PG8_BAR; PG8_WAIT_L(0); PG8_MMA(0, 1, At, B1); PG8_BAR;
            PG8_LDA(At, 0, 1); PG8_STAGE(PG8_SA(0, 0), a2, voffA);
            PG8_BAR; PG8_WAIT_L(0); PG8_MMA(1, 0, At, B0); PG8_BAR; PG8_SCHED;
            PG8_STAGE(PG8_SB(0, 1), b2 + hstep, voffB);
            PG8_WAIT_V(6); PG8_BAR; PG8_MMA(1, 1, At, B1); PG8_BAR;
            PG8_LDB(B0, 1, 0); PG8_SCHED; PG8_LDA(At, 1, 0); PG8_STAGE(PG8_SA(0, 1), a2 + hstep, voffA);
            PG8_WAIT_L(8); PG8_BAR; PG8_WAIT_L(0); PG8_MMA(0, 0, At, B0); PG8_BAR; PG8_SCHED;
            PG8_LDB(B1, 1, 1); PG8_STAGE(PG8_SB(1, 0), b3, voffB);
            PG8_BAR; PG8_WAIT_L(0); PG8_MMA(0, 1, At, B1); PG8_BAR;
            PG8_LDA(At, 1, 1); PG8_STAGE(PG8_SA(1, 0), a3, voffA);
            PG8_BAR; PG8_WAIT_L(0); PG8_MMA(1, 0, At, B0); PG8_BAR; PG8_SCHED;
            PG8_STAGE(PG8_SB(1, 1), b3 + hstep, voffB);
            PG8_WAIT_V(6); PG8_BAR; PG8_MMA(1, 1, At, B1); PG8_BAR;
            }
        }
        if constexpr (ALIGN_EPI) { if (wr == 0) PG8_BAR; }
        if constexpr (!Epi::AFTER_DRAIN) { E(acc, cur, wr, wc, fr, fq); S.done(cur); }
        if (!has_next) break;
#pragma unroll
        for (int a = 0; a < 2; ++a)
#pragma unroll
            for (int b = 0; b < 2; ++b)
#pragma unroll
                for (int m = 0; m < 4; ++m)
#pragma unroll
                    for (int n = 0; n < 2; ++n) acc[a][b][m][n] = (f32x4){0.f, 0.f, 0.f, 0.f};
        cur = nxt; cA = nA; cB = nB; ++ui;
        if constexpr (ALIGN_EPI) { if (wr == 1) PG8_BAR; }
    }
    PG8_WAIT_V(0);
    if constexpr (!ALIGN_EPI) { if (wr == 0) PG8_BAR; }
    PG8_BAR;
    if constexpr (Epi::AFTER_DRAIN) { E.fused(acc, cur, wr, wc, fr, fq, lds, wid, lane); S.done(cur); }
#undef PG8_SA
#undef PG8_SB
#undef PG8_STAGE
#undef PG8_LDA
#undef PG8_LDB
#undef PG8_MMA
#undef PG8_WAIT_V
#undef PG8_WAIT_L
#undef PG8_BAR
#undef PG8_SCHED
}
}
namespace attn_body {
using bf16=__hip_bfloat16;
using bf16x8=__attribute__((ext_vector_type(8)))short;
using s16x4=__attribute__((ext_vector_type(4)))short;
using f32x16=__attribute__((ext_vector_type(16)))float;
using u32x4=__attribute__((ext_vector_type(4)))unsigned;
constexpr int BATCH=8,NHEAD=8,SEQ=4096,D=64,DM=NHEAD*D,DMO=1024;
constexpr int NW=8,QBLK=32,QB=QBLK*NW,KVBLK=64,NQB=SEQ/QB;
constexpr int ATTN_PITCH=DM, ATTN_UNIT_ROWS=QB;
constexpr int LDS_CK_OFF=83968;
__device__ __forceinline__ int crow(int r,int hi){return (r&3)+8*(r>>2)+4*hi;}
#define SBAR() __builtin_amdgcn_sched_barrier(0)
__device__ __forceinline__ void cmask(f32x16&p0,f32x16&p1,int jb,int qrel,int hi){
  const float NEG=-INFINITY; int kb=64*jb+4*hi;
  #pragma unroll
  for(int r=0;r<16;++r){int kv=kb+(r&3)+8*(r>>2); if(kv>qrel)p0[r]=NEG; if(kv+32>qrel)p1[r]=NEG;}
}

constexpr int NSLOT=3, SLOTB=8192;
constexpr int LDS_K=0, LDS_V=NSLOT*SLOTB, LDS_WS=2*NSLOT*SLOTB, LDS_OST=LDS_WS+NW*64*4, LDS_BYTES=LDS_OST+NW*4096;
constexpr float C2=0.125f*1.4426950408889634f;
__device__ __forceinline__ void glds16(const void*gsrc,unsigned lds_dst){unsigned keep;
  asm volatile("s_mov_b32 %0, m0\n\ts_mov_b32 m0, %2\n\ts_nop 0\n\tglobal_load_lds_dwordx4 %1, off\n\ts_mov_b32 m0, %0":"=&s"(keep):"v"(gsrc),"s"(lds_dst):"memory");}
__device__ __forceinline__ float max3f(float a,float b,float c){float r;asm("v_max3_f32 %0, %1, %2, %3":"=v"(r):"v"(a),"v"(b),"v"(c));return r;}
__device__ __forceinline__ float max2f(float a,float b){float r;asm("v_max_f32_e32 %0, %1, %2":"=v"(r):"v"(a),"v"(b));return r;}
__device__ __forceinline__ float fadd_s(float a,float b){float r;asm("v_add_f32_e32 %0, %1, %2":"=v"(r):"v"(a),"v"(b));return r;}
__device__ __forceinline__ float fsub_s(float a,float b){float r;asm("v_sub_f32_e32 %0, %1, %2":"=v"(r):"v"(a),"v"(b));return r;}
typedef float f32x2_t __attribute__((ext_vector_type(2))); typedef __bf16 bf16x2_t __attribute__((ext_vector_type(2)));
__device__ __forceinline__ unsigned cvtpk_s(float lo,float hi){f32x2_t v={lo,hi};bf16x2_t b=__builtin_convertvector(v,bf16x2_t);return __builtin_bit_cast(unsigned,b);}
#define WAIT_BAR(N) asm volatile("s_waitcnt vmcnt(" #N ") lgkmcnt(0)\n\ts_barrier":::"memory")

__device__ __forceinline__ void qkt(f32x16&p0,f32x16&p1,const char*Kslot,const bf16x8*qr,const f32x16&ini0,const f32x16&ini1,int r32,int hi){
  const char*kb=Kslot+hi*1024+r32*16;
  #pragma unroll
  for(int d0=0;d0<4;++d0){
    const bf16x8 b0=*reinterpret_cast<const bf16x8*>(kb+d0*2048);
    const bf16x8 b1=*reinterpret_cast<const bf16x8*>(kb+d0*2048+512);
    if(d0==0){p0=__builtin_amdgcn_mfma_f32_32x32x16_bf16(b0,qr[0],ini0,0,0,0);p1=__builtin_amdgcn_mfma_f32_32x32x16_bf16(b1,qr[0],ini1,0,0,0);}
    else{p0=__builtin_amdgcn_mfma_f32_32x32x16_bf16(b0,qr[d0],p0,0,0,0);p1=__builtin_amdgcn_mfma_f32_32x32x16_bf16(b1,qr[d0],p1,0,0,0);}}
}
typedef __attribute__((address_space(3))) const char* lds_cptr;
typedef short v4i16_t __attribute__((ext_vector_type(4)));
__device__ __forceinline__ void kload8(bf16x8*kf,lds_cptr kp){
  kf[0]=*(const __attribute__((address_space(3))) bf16x8*)(kp);      kf[1]=*(const __attribute__((address_space(3))) bf16x8*)(kp+512);
  kf[2]=*(const __attribute__((address_space(3))) bf16x8*)(kp+2048); kf[3]=*(const __attribute__((address_space(3))) bf16x8*)(kp+2560);
  kf[4]=*(const __attribute__((address_space(3))) bf16x8*)(kp+4096); kf[5]=*(const __attribute__((address_space(3))) bf16x8*)(kp+4608);
  kf[6]=*(const __attribute__((address_space(3))) bf16x8*)(kp+6144); kf[7]=*(const __attribute__((address_space(3))) bf16x8*)(kp+6656);
}
__device__ __forceinline__ void kload2(bf16x8*kf,lds_cptr kp,int j){ kf[2*j]=*(const __attribute__((address_space(3))) bf16x8*)(kp+j*2048); kf[2*j+1]=*(const __attribute__((address_space(3))) bf16x8*)(kp+j*2048+512); }
__device__ __forceinline__ s16x4 vtr(lds_cptr p){ return __builtin_bit_cast(s16x4,__builtin_amdgcn_ds_read_tr16_b64_v4i16((__attribute__((address_space(3))) v4i16_t*)p)); }
__device__ __forceinline__ float rowmax(const f32x16&p0,const f32x16&p1){
  float a=max3f(p0[0],p0[1],p1[0]),b=max3f(p0[2],p0[3],p1[1]);a=max3f(a,p1[2],p1[3]);
  #pragma unroll
  for(int r=4;r<16;r+=4){a=max3f(a,p0[r],p0[r+1]);b=max3f(b,p0[r+2],p0[r+3]);a=max3f(a,p1[r],p1[r+1]);b=max3f(b,p1[r+2],p1[r+3]);}
  const float m=max2f(a,b);
  auto rr=__builtin_amdgcn_permlane32_swap(__float_as_uint(m),__float_as_uint(m),false,false);
  return max2f(__uint_as_float(rr[0]),__uint_as_float(rr[1]));
}
__device__ __forceinline__ void pv(f32x16*o,int vb,bf16x8 pa0,bf16x8 pa1,bf16x8 pa2,bf16x8 pa3){
  #pragma unroll
  for(int d0=0;d0<2;++d0){s16x4 lo[4],hi[4];
    #pragma unroll
    for(int ks=0;ks<4;++ks){
      asm volatile("ds_read_b64_tr_b16 %0,%1 offset:%c2":"=&v"(lo[ks]):"v"(vb),"i"(d0*4096+ks*1024):"memory");
      asm volatile("ds_read_b64_tr_b16 %0,%1 offset:%c2":"=&v"(hi[ks]):"v"(vb),"i"(d0*4096+ks*1024+512):"memory");}
    asm volatile("s_waitcnt lgkmcnt(0)":::"memory");SBAR();
    #define PK(k) (bf16x8){lo[k][0],lo[k][1],lo[k][2],lo[k][3],hi[k][0],hi[k][1],hi[k][2],hi[k][3]}
    o[d0]=__builtin_amdgcn_mfma_f32_32x32x16_bf16(pa0,PK(0),o[d0],0,0,0);
    o[d0]=__builtin_amdgcn_mfma_f32_32x32x16_bf16(pa1,PK(1),o[d0],0,0,0);
    o[d0]=__builtin_amdgcn_mfma_f32_32x32x16_bf16(pa2,PK(2),o[d0],0,0,0);
    o[d0]=__builtin_amdgcn_mfma_f32_32x32x16_bf16(pa3,PK(3),o[d0],0,0,0);
    #undef PK
  }
}

#ifndef ATTN_STORE16
#define ATTN_STORE16(p,v) (*(u32x4*)(p)=(v))
#endif
template<int THRL> __device__ __forceinline__ void attn_unit(int b,int h,int qb,const bf16*Q,const bf16*__restrict__ K,const bf16*__restrict__ V,bf16*O,const float*CB,char*shm){
  const int tid=threadIdx.x,lane=tid&63,r32=lane&31,hi=lane>>5; const int wid=__builtin_amdgcn_readfirstlane(tid>>6);
  const long rowbase=(long)b*SEQ; const int q0=qb*QB;
  typedef float f32x4_t __attribute__((ext_vector_type(4)));
  const float*cbh=CB+(long)(b*NHEAD+h)*SEQ;
  { const int n4=(q0+QB)/4; __attribute__((address_space(3))) f32x4_t*ckl=(__attribute__((address_space(3))) f32x4_t*)((lds_cptr)shm+LDS_CK_OFF);
    for(int i=tid;i<n4;i+=NW*64)ckl[i]=((const f32x4_t*)cbh)[i]; }
  const bf16*Qw=Q+(rowbase+q0+wid*QBLK)*DM+h*D;
  const bf16*Kh=K+rowbase*DM+h*D,*Vh=V+rowbase*DM+h*D;
  const unsigned lds0=(unsigned)(uintptr_t)shm;
  float*wsf=(float*)(shm+LDS_WS)+wid*64;
  const bf16*ksrc=Kh+(long)lane*DM+wid*8;
  const bf16*vsrc=Vh+(long)(16*(wid&3)+(lane>>2))*DM+(wid>>2)*32+(lane&3)*8;
  const unsigned kdst=lds0+LDS_K+wid*1024, vdst=lds0+LDS_V+wid*1024;
  #define DMA_K(t,slot) glds16(ksrc+(long)(t)*KVBLK*DM,(unsigned)__builtin_amdgcn_readfirstlane(kdst+(slot)))
  #define DMA_V(t,slot) glds16(vsrc+(long)(t)*KVBLK*DM,(unsigned)__builtin_amdgcn_readfirstlane(vdst+(slot)))
  const int vb0=(int)(lds0+LDS_V)+((lane>>4)&1)*32+(lane&3)*8+(4*hi+((lane&15)>>2))*64;
  const char*Kbase=shm+LDS_K; bf16x8 kf[8];
  const lds_cptr shm3=(lds_cptr)shm; const lds_cptr kp0=shm3+LDS_K+hi*1024+r32*16; const lds_cptr vp0=shm3+LDS_V+((lane>>4)&1)*32+(lane&3)*8+(4*hi+((lane&15)>>2))*64;
  const int NT=(q0+QB)/KVBLK;
  DMA_K(0,0);DMA_V(0,0);DMA_K(1,SLOTB);
  bf16x8 qr[4];
  #pragma unroll
  for(int d0=0;d0<4;++d0)qr[d0]=*reinterpret_cast<const bf16x8*>(&Qw[(long)r32*DM+d0*16+hi*8]);
  float mhat,l_reg=0.f;f32x16 o[2];o[0]=f32x16{};o[1]=f32x16{};
  const float cq=cbh[q0+wid*QBLK+r32];
  {
    const bf16*Kw=Kh+(long)(q0+wid*QBLK+r32)*DM; float sd=0.f;
    _Pragma("unroll") for(int d0=0;d0<4;++d0){ const bf16x8 kk=*reinterpret_cast<const bf16x8*>(&Kw[d0*16+hi*8]);
      _Pragma("unroll") for(int j=0;j<8;++j) sd+=__uint_as_float((unsigned)(unsigned short)qr[d0][j]<<16)*__uint_as_float((unsigned)(unsigned short)kk[j]<<16); }
    auto rs_=__builtin_amdgcn_permlane32_swap(__float_as_uint(sd),__float_as_uint(sd),false,false); mhat=__uint_as_float(rs_[0])+__uint_as_float(rs_[1]); }
  float cqm=cq-mhat;
  const __attribute__((address_space(3))) float*ckb=(const __attribute__((address_space(3))) float*)((lds_cptr)shm+LDS_CK_OFF)+4*hi;
  #define CINIT(C0,C1,t) do{ const __attribute__((address_space(3))) float*cp_=ckb+64*(t); \
    _Pragma("unroll") for(int g_=0;g_<4;++g_){ const f32x4_t a_=*(const __attribute__((address_space(3))) f32x4_t*)(cp_+8*g_), b_=*(const __attribute__((address_space(3))) f32x4_t*)(cp_+32+8*g_); \
      _Pragma("unroll") for(int j_=0;j_<4;++j_){ C0[4*g_+j_]=cqm-a_[j_]; C1[4*g_+j_]=cqm-b_[j_]; } } }while(0)
  const int qrel=wid*QBLK+r32;
  #define CMASK(P0,P1,t) do{int jb_=(t)-(NT-4); if(jb_>=0)cmask(P0,P1,jb_,qrel,hi);}while(0)
  bool resc=false;
  #define START(P0,P1) do{ const float rm=rowmax(P0,P1); resc=false; \
    { const float dl=max2f(rm,0.f); mhat=fadd_s(mhat,dl); \
      _Pragma("unroll") for(int r=0;r<16;++r){P0[r]=fsub_s(P0[r],dl);P1[r]=fsub_s(P1[r],dl);} \
      cqm=cq-mhat; } \
    _Pragma("unroll") for(int r=0;r<16;++r)P0[r]=__builtin_amdgcn_exp2f(P0[r]); }while(0)
  #define RESC() do{ if(resc){ asm volatile("s_waitcnt lgkmcnt(0)":::"memory"); \
      _Pragma("unroll") for(int d_=0;d_<2;++d_) _Pragma("unroll") for(int r=0;r<16;++r)o[d_][r]*=wsf[crow(r,hi)]; } }while(0)
  f32x16 pA0,pA1,pB0,pB1;
  int sl_prev=0,sl_cur=0,sl_next=SLOTB;
  #define ROT() do{sl_prev=sl_cur;sl_cur=sl_next;sl_next=(sl_next==(NSLOT-1)*SLOTB)?0:sl_next+SLOTB;}while(0)
  DMA_K(2,2*SLOTB);
  WAIT_BAR(3);
  { f32x16 i0_,i1_; CINIT(i0_,i1_,0); qkt(pA0,pA1,Kbase,qr,i0_,i1_,r32,hi); } asm volatile("s_nop 15\n\ts_nop 7":"+v"(pA0),"+v"(pA1));CMASK(pA0,pA1,0);
  START(pA0,pA1);
  _Pragma("unroll") for(int r=0;r<16;++r)pA1[r]=__builtin_amdgcn_exp2f(pA1[r]);
  WAIT_BAR(0);
  DMA_K(3,0);DMA_V(1,SLOTB);
  ROT();
  kload8(kf,kp0+sl_cur);
  WAIT_BAR(2);
  s16x4 vlo[8],vhi[8]; u32x4 pw0,pw1,pw2,pw3;
  #define PKW(P,B) cvtpk_s(P[B],P[B+1])
  #define PAF(k) __builtin_bit_cast(bf16x8,pw##k)
  #define VFR(i) (bf16x8){vlo[i][0],vlo[i][1],vlo[i][2],vlo[i][3],vhi[i][0],vhi[i][1],vhi[i][2],vhi[i][3]}
  #define PIN(x) asm volatile("":"+v"(x))
  #define MX3(a,b,c) __builtin_fmaxf(__builtin_fmaxf((a),(b)),(c))
  #define GAPA(MF,A0,A1,A2,A3,W0,W1,PW) do{ MF; sacc+=A0; sacc+=A1; sacc+=A2; sacc+=A3; PIN(sacc); W0; W1; PIN(PW); SBAR(); }while(0)
  #define EX(v) __builtin_amdgcn_exp2f(v)
  #define GAPB(MF,X,B) do{ MF; X[B]=EX(X[B]); X[B+1]=EX(X[B+1]); X[B+2]=EX(X[B+2]); X[B+3]=EX(X[B+3]); PIN(X); SBAR(); }while(0)
  #define VRD(i) do{ vlo[i]=vtr(vp_+(((i)>>2)*4096+((i)&3)*1024)); vhi[i]=vtr(vp_+(((i)>>2)*4096+((i)&3)*1024+512)); }while(0)
  #define KRD(G,j) do{ if(G){ kload2(kf,kp0+sl_next,j); SBAR(); } }while(0)
  #define STEP(C0,C1,P0,P1,t,GK,GV,GL) do{ SBAR(); CINIT(C0,C1,t); SBAR(); \
    const lds_cptr vp_=vp0+sl_prev; \
    VRD(0); SBAR(); float sacc=(P0[0]+P0[1]); \
    GAPA(C0=__builtin_amdgcn_mfma_f32_32x32x16_bf16(kf[0],qr[0],C0,0,0,0), P0[2],P0[3],P0[4],P0[5],     pw0[0]=PKW(P0,0), pw0[1]=PKW(P0,2), pw0); \
    VRD(4); SBAR(); GAPA(C1=__builtin_amdgcn_mfma_f32_32x32x16_bf16(kf[1],qr[0],C1,0,0,0), P0[6],P0[7],P0[8],P0[9],     pw0[2]=PKW(P0,4), pw0[3]=PKW(P0,6), pw0); \
    VRD(1); SBAR(); GAPA(C0=__builtin_amdgcn_mfma_f32_32x32x16_bf16(kf[2],qr[1],C0,0,0,0),   P0[10],P0[11],P0[12],P0[13], pw1[0]=PKW(P0,8), pw1[1]=PKW(P0,10), pw1); \
    VRD(5); SBAR(); GAPA(C1=__builtin_amdgcn_mfma_f32_32x32x16_bf16(kf[3],qr[1],C1,0,0,0),   P0[14],P0[15],P1[0],P1[1],   pw1[2]=PKW(P0,12),pw1[3]=PKW(P0,14), pw1); \
    VRD(2); SBAR(); GAPA(C0=__builtin_amdgcn_mfma_f32_32x32x16_bf16(kf[4],qr[2],C0,0,0,0),   P1[2],P1[3],P1[4],P1[5],     pw2[0]=PKW(P1,0), pw2[1]=PKW(P1,2), pw2); \
    VRD(6); SBAR(); GAPA(C1=__builtin_amdgcn_mfma_f32_32x32x16_bf16(kf[5],qr[2],C1,0,0,0),   P1[6],P1[7],P1[8],P1[9],     pw2[2]=PKW(P1,4), pw2[3]=PKW(P1,6), pw2); \
    VRD(3); SBAR(); GAPA(C0=__builtin_amdgcn_mfma_f32_32x32x16_bf16(kf[6],qr[3],C0,0,0,0),   P1[10],P1[11],P1[12],P1[13], pw3[0]=PKW(P1,8), pw3[1]=PKW(P1,10), pw3); \
    VRD(7); SBAR(); GAPA(C1=__builtin_amdgcn_mfma_f32_32x32x16_bf16(kf[7],qr[3],C1,0,0,0),   P1[14],P1[15],0.f,0.f,       pw3[2]=PKW(P1,12),pw3[3]=PKW(P1,14), pw3); \
    l_reg+=sacc; \
    if(GK){DMA_K((t)+3,sl_cur);} if(GV){DMA_V((t)+1,sl_next);} \
    CMASK(C0,C1,t); \
    { float a=MX3(C0[0],C0[1],C1[0]),b=MX3(C0[2],C0[3],C1[1]); a=MX3(a,C1[2],C1[3]); \
      _Pragma("unroll") for(int r=4;r<16;r+=4){a=MX3(a,C0[r],C0[r+1]);b=MX3(b,C0[r+2],C0[r+3]);a=MX3(a,C1[r],C1[r+1]);b=MX3(b,C1[r+2],C1[r+3]);} \
      float rm=__builtin_fmaxf(a,b); { auto rr=__builtin_amdgcn_permlane32_swap(__float_as_uint(rm),__float_as_uint(rm),false,false); rm=__builtin_fmaxf(__uint_as_float(rr[0]),__uint_as_float(rr[1])); } \
      resc=false; \
      if(__builtin_expect(__any(rm>(float)THRL),0)){ const float dl=__builtin_fmaxf(rm,0.f); mhat+=dl; \
        _Pragma("unroll") for(int r=0;r<16;++r){C0[r]-=dl;C1[r]-=dl;} \
        cqm=cq-mhat; \
        const float f=__builtin_amdgcn_exp2f(-dl); l_reg*=f; if(hi==0)wsf[r32]=f; resc=true; } } \
    SBAR(); \
    GAPB(o[0]=__builtin_amdgcn_mfma_f32_32x32x16_bf16(PAF(0),VFR(0),o[0],0,0,0), C0,0); \
    GAPB(o[1]=__builtin_amdgcn_mfma_f32_32x32x16_bf16(PAF(0),VFR(4),o[1],0,0,0), C0,4); \
    KRD(GL,0); GAPB(o[0]=__builtin_amdgcn_mfma_f32_32x32x16_bf16(PAF(1),VFR(1),o[0],0,0,0), C0,8); \
    KRD(GL,1); GAPB(o[1]=__builtin_amdgcn_mfma_f32_32x32x16_bf16(PAF(1),VFR(5),o[1],0,0,0), C0,12); \
    KRD(GL,2); GAPB(o[0]=__builtin_amdgcn_mfma_f32_32x32x16_bf16(PAF(2),VFR(2),o[0],0,0,0), C1,0); \
    KRD(GL,3); GAPB(o[1]=__builtin_amdgcn_mfma_f32_32x32x16_bf16(PAF(2),VFR(6),o[1],0,0,0), C1,4); \
    GAPB(o[0]=__builtin_amdgcn_mfma_f32_32x32x16_bf16(PAF(3),VFR(3),o[0],0,0,0), C1,8); \
    GAPB(o[1]=__builtin_amdgcn_mfma_f32_32x32x16_bf16(PAF(3),VFR(7),o[1],0,0,0), C1,12); \
    }while(0)
  int t=1;
  #undef CMASK
  #define CMASK(P0,P1,t) do{}while(0)
  for(;t+5<NT;t+=2){
    STEP(pB0,pB1,pA0,pA1,t,true,true,true);     WAIT_BAR(2); RESC(); ROT();
    STEP(pA0,pA1,pB0,pB1,t+1,true,true,true);   WAIT_BAR(2); RESC(); ROT();
  }
  #undef CMASK
  #define CMASK(P0,P1,t) do{int jb_=(t)-(NT-4); if(jb_>=0)cmask(P0,P1,jb_,qrel,hi);}while(0)
  #define ENDW(tt) do{ if((tt)+3<NT){WAIT_BAR(2);} else if((tt)+2<NT){WAIT_BAR(1);} else {WAIT_BAR(0);} }while(0)
  for(;t+1<NT;t+=2){
    STEP(pB0,pB1,pA0,pA1,t,(t+3<NT),(t+1<NT),(t+1<NT));       ENDW(t);   RESC(); ROT();
    STEP(pA0,pA1,pB0,pB1,t+1,(t+4<NT),(t+2<NT),(t+2<NT));     ENDW(t+1); RESC(); ROT();
  }
  STEP(pB0,pB1,pA0,pA1,NT-1,false,false,false); RESC();
  { float sacc=pB0[0]+pB0[1]; _Pragma("unroll") for(int r=2;r<16;++r)sacc+=pB0[r]; _Pragma("unroll") for(int r=0;r<16;++r)sacc+=pB1[r]; l_reg+=sacc;
    pw0=(u32x4){PKW(pB0,0),PKW(pB0,2),PKW(pB0,4),PKW(pB0,6)};pw1=(u32x4){PKW(pB0,8),PKW(pB0,10),PKW(pB0,12),PKW(pB0,14)};pw2=(u32x4){PKW(pB1,0),PKW(pB1,2),PKW(pB1,4),PKW(pB1,6)};pw3=(u32x4){PKW(pB1,8),PKW(pB1,10),PKW(pB1,12),PKW(pB1,14)};
    SBAR(); pv(o,vb0+sl_cur,PAF(0),PAF(1),PAF(2),PAF(3)); }
  #undef PKW
  #undef PAF
  #undef VFR
  #undef PIN
  #undef MX3
  #undef GAPA
  #undef GAPB
  #undef EX
  #undef VRD
  #undef KRD
  #undef STEP
  #undef ENDW
  {auto rr=__builtin_amdgcn_permlane32_swap(__float_as_uint(l_reg),__float_as_uint(l_reg),false,false);l_reg=__uint_as_float(rr[0])+__uint_as_float(rr[1]);}
  if(hi==0)wsf[32+r32]=l_reg;asm volatile("s_waitcnt lgkmcnt(0)":::"memory");
  float rli[16];
  #pragma unroll
  for(int r=0;r<16;++r)rli[r]=__builtin_amdgcn_rcpf(wsf[32+crow(r,hi)]);
  bf16*Ow=O+(rowbase+q0+wid*QBLK)*DMO+h*D;
  { bf16*stg=(bf16*)(shm+LDS_OST)+wid*2048;
    #pragma unroll
    for(int r=0;r<16;++r){const int orow=crow(r,hi);
      #pragma unroll
      for(int d0=0;d0<2;++d0)stg[orow*64+d0*32+r32]=__float2bfloat16(o[d0][r]*rli[r]);}
    asm volatile("s_waitcnt lgkmcnt(0)":::"memory");
    #pragma unroll
    for(int i=0;i<4;++i){const int row=i*8+(lane>>3),ch=lane&7; const u32x4 v=*(const u32x4*)(stg+row*64+ch*8); ATTN_STORE16(Ow+(long)row*DMO+ch*8,v);} }
  asm volatile("s_waitcnt lgkmcnt(0)\n\ts_barrier":::"memory");
  #undef CINIT
  #undef DMA_K
  #undef DMA_V
  #undef CMASK
  #undef START
  #undef RESC
  #undef ROT
}
constexpr int ATTN_LDS_BYTES=LDS_BYTES;
struct AttnTensors { const bf16* Q; const bf16* K; const bf16* V; bf16* O; const float* CB; };
struct AttnUnit { int bh; int qb; };
struct StaticOrder {
  int vcu;
  __device__ __forceinline__ explicit StaticOrder(int grid,int block):vcu((block%8)*(grid/8)+block/8){}
  __device__ __forceinline__ bool next(int i,AttnUnit&u)const{ if(i>=4||vcu>=64*4)return false; const int s=vcu&3; u.bh=vcu>>2; u.qb=(i==0)?s:(i==1)?7-s:(i==2)?8+s:15-s; return true; }
  __device__ __forceinline__ void a_ready(const AttnUnit&)const{}
  __device__ __forceinline__ void done(const AttnUnit&)const{}
};
template<class Sched,int THRL=8> __device__ __forceinline__ void attn_phase(char*lds,const AttnTensors&T,const Sched&S){
  AttnUnit u;
  for(int i=0;S.next(i,u);++i){ S.a_ready(u); attn_unit<THRL>(u.bh/NHEAD,u.bh%NHEAD,u.qb,T.Q,T.K,T.V,T.O,T.CB,lds); S.done(u); }
}
#undef SBAR
#undef WAIT_BAR
}
#define GAS __attribute__((address_space(1)))
#define LAS __attribute__((address_space(3)))
typedef unsigned short bf16;
typedef unsigned v4u __attribute__((ext_vector_type(4)));
typedef float f32x4 __attribute__((ext_vector_type(4)));
typedef short bf16x8 __attribute__((ext_vector_type(8)));
typedef GAS unsigned gu32;
typedef GAS unsigned long long gu64;
#define RLX_AGENT __ATOMIC_RELAXED, __HIP_MEMORY_SCOPE_AGENT
#define LDS_WAIT() asm volatile("s_waitcnt lgkmcnt(0)" ::: "memory")
#define VM_WAIT() asm volatile("s_waitcnt vmcnt(0)" ::: "memory")
__device__ __forceinline__ unsigned long long rt() { return __builtin_amdgcn_s_memrealtime(); }
__device__ __forceinline__ unsigned f2bf(float f) { unsigned u = __builtin_bit_cast(unsigned, f); return (u + 0x7fffu + ((u >> 16) & 1u)) >> 16; }
__device__ __forceinline__ unsigned pk2(float lo, float hi) { return f2bf(lo) | (f2bf(hi) << 16); }

#define XB_TMO      128
#define XB_XCNT(j)  (256  + 64 * (j))
#define XB_XSUB(j)  (1280 + 64 * (j))
#define XB_XGEN(j)  (2304 + 64 * (j))
#define XB_TOP      3328
#define XB_TOPGEN   3392
#define XCD_BAR_WORDS 3456
#define XB_SPIN_CAP (1u << 18)

__device__ __forceinline__ unsigned xb_ld(unsigned* p)              { return __hip_atomic_load(p, __ATOMIC_RELAXED, __HIP_MEMORY_SCOPE_AGENT); }
__device__ __forceinline__ unsigned xb_add(unsigned* p, unsigned v) { return __hip_atomic_fetch_add(p, v, __ATOMIC_RELAXED, __HIP_MEMORY_SCOPE_AGENT); }
__device__ __forceinline__ unsigned xb_xcc_id() { return (unsigned)__builtin_amdgcn_s_getreg((3 << 11) | 20) & 0xFu; }
#define XB_SPIN(cond, bar) do { unsigned _sp = 0; while (cond) { __builtin_amdgcn_s_sleep(1); \
    if ((++_sp & 255u) == 0u) { if (xb_ld(&(bar)[XB_TMO])) break; if (_sp > XB_SPIN_CAP) { atomicAdd(&(bar)[XB_TMO], 1u); break; } } } } while (0)

struct XcdBarrier {
    unsigned* bar; unsigned x;
    volatile LAS unsigned* st;
};

__device__ __forceinline__ XcdBarrier xcd_barrier_post(unsigned* bar, volatile LAS unsigned* st) {
    XcdBarrier b; b.bar = bar; b.x = xb_xcc_id(); b.st = st;
    if (threadIdx.x == 0) (void)xb_add(&bar[XB_XCNT(b.x)], 1u);
    return b;
}
__device__ __forceinline__ void xcd_barrier_complete(unsigned* bar, unsigned x, unsigned& nloc, unsigned& nx) {
    const unsigned G = gridDim.x * gridDim.y * gridDim.z;
    unsigned sum, cnt, mine, sp = 0u;
    for (;;) {
        sum = 0u; cnt = 0u; mine = 0u;
#pragma unroll
        for (unsigned j = 0; j < 16; ++j) { const unsigned c = xb_ld(&bar[XB_XCNT(j)]); sum += c; cnt += (c > 0u) ? 1u : 0u; mine = (j == x) ? c : mine; }
        if (sum == G) break;
        __builtin_amdgcn_s_sleep(1);
        if ((++sp & 255u) == 0u) { if (xb_ld(&bar[XB_TMO])) break; if (sp > XB_SPIN_CAP) { atomicAdd(&bar[XB_TMO], 1u); break; } }
    }
    nloc = mine > 0u ? mine : 1u; nx = cnt > 0u ? cnt : 1u;
}

__device__ __forceinline__ void xcd_barrier(const XcdBarrier& b) {
    asm volatile("s_waitcnt vmcnt(0)" ::: "memory");
    __syncthreads();
    if (threadIdx.x == 0) {
        unsigned* bar = b.bar;
        __builtin_amdgcn_s_waitcnt(0);
        unsigned nloc = b.st[0], nx = b.st[1];
        if (nloc == 0u) { xcd_barrier_complete(bar, b.x, nloc, nx); b.st[0] = nloc; b.st[1] = nx; }
        const unsigned old = xb_add(&bar[XB_XSUB(b.x)], 1u);
        const unsigned gen = old / nloc;
        if (old + 1u == (gen + 1u) * nloc) {
            __builtin_amdgcn_fence(__ATOMIC_RELEASE, "agent");
            asm volatile("s_waitcnt vmcnt(0)" ::: "memory");
            const unsigned og = xb_add(&bar[XB_TOP], 1u);
            const unsigned tg = og / nx;
            if (og + 1u == (tg + 1u) * nx) xb_add(&bar[XB_TOPGEN], 1u);
            else XB_SPIN(xb_ld(&bar[XB_TOPGEN]) == tg, bar);
            __builtin_amdgcn_fence(__ATOMIC_ACQUIRE, "agent");
            xb_add(&bar[XB_XGEN(b.x)], 1u);
            asm volatile("s_waitcnt vmcnt(0)" ::: "memory");
        } else {
            XB_SPIN(xb_ld(&bar[XB_XGEN(b.x)]) == gen, bar);
            __builtin_amdgcn_fence(__ATOMIC_ACQUIRE, "agent");
            asm volatile("s_waitcnt vmcnt(0)" ::: "memory");
        }
    }
    __syncthreads();
}

constexpr int NWAVES = 8;
constexpr int NB = 8, SEQ = 4096, DM = 1024, MTOK = NB * SEQ, DFF = 4096;
constexpr float LOG2E = 1.4426950408889634f;
constexpr size_t MiB = 1u << 20;
constexpr size_t WS_CTL = 0, CTL_ZERO_BYTES = 1 * MiB;
constexpr size_t WS_WIN0 = 1 * MiB, WS_WGLU = 5 * MiB, WS_WOUT0 = 6 * MiB, WS_WUP0 = 8 * MiB, WS_WDN0 = 16 * MiB, WS_WIN1 = 24 * MiB, WS_WOUT1 = 31 * MiB, WS_WUP1 = 33 * MiB, WS_WDN1 = 41 * MiB;
constexpr size_t WS_SSP = 49 * MiB;
constexpr size_t WS_LOGF = 51 * MiB;
constexpr size_t WS_CB = 52 * MiB;
constexpr size_t WS_ROT = 53 * MiB;
constexpr size_t WS_XB = 64 * MiB;
constexpr size_t WS_BIG = 128 * MiB;
constexpr size_t WS_Q = 128 * MiB, WS_K = 160 * MiB, WS_V = 192 * MiB, WS_U = 224 * MiB, WS_YG = 256 * MiB, WS_MIX = 288 * MiB;
constexpr size_t WS_P1 = 128 * MiB;
constexpr size_t WS_MIX1 = 352 * MiB;
constexpr size_t WS_KV = 416 * MiB;
constexpr size_t WS_END = 480 * MiB;
constexpr size_t P1_STRIDE = 32 * MiB / 2;
constexpr int CW_TMO = 0, CW_CODE = 1, CW_BAR = 4096;
constexpr int RING_OFF = 0, RING_BYTES = 131072;
constexpr int LDSCTL_OFF = RING_BYTES, MISC_OFF = LDSCTL_OFF + 320;
constexpr int LDS_BYTES = 147456;


struct Frame {
    LAS unsigned char* lds;
    volatile LAS unsigned* MISC;
    gu32* ctl;
    int tid, lane, wave;
    int vcu, G;
};
struct Args { const float* in[23]; float* out; unsigned char* ws; int ph_lo, ph_hi, li, pad; };

__device__ __forceinline__ float wave_sum(float v) {
#pragma unroll
    for (int o = 1; o < 64; o <<= 1) v += __shfl_xor(v, o);
    return v;
}
__device__ __forceinline__ float bf2f(unsigned short u) { return __uint_as_float((unsigned)u << 16); }

__device__ __forceinline__ void p0_transpose_item(const float* W, int ldw, int scol, int K, int ncols, bf16* WT, int drow, const float* gain, float scale, LAS float* scr, int item, int lane) {
    const int nblk = ncols / 32, kb = item / nblk, nb = item % nblk, k0 = 64 * kb, n0 = 32 * nb;
#pragma unroll 8
    for (int i = 0; i < 32; ++i) { const int kk = 2 * i + (lane >> 5); float v = W[(size_t)(k0 + kk) * ldw + scol + n0 + (lane & 31)]; if (gain) v *= gain[k0 + kk]; scr[kk * 33 + (lane & 31)] = v * scale; }
    LDS_WAIT(); asm volatile("" ::: "memory");
    const int c = lane & 7;
#pragma unroll
    for (int j = 0; j < 4; ++j) { const int n = (lane >> 3) + 8 * j; const LAS float* s = scr + (8 * c) * 33 + n;
        v4u o; o.x = pk2(s[0 * 33], s[1 * 33]); o.y = pk2(s[2 * 33], s[3 * 33]); o.z = pk2(s[4 * 33], s[5 * 33]); o.w = pk2(s[6 * 33], s[7 * 33]);
        *(GAS v4u*)(WT + (size_t)(drow + n0 + n) * K + k0 + 8 * c) = o; }
    LDS_WAIT(); asm volatile("" ::: "memory");
}
__device__ __forceinline__ void rot_entry(int pos, int f, float& co, float& si) {
    const double inv = exp2(-(double)f * (13.287712379549449 / 63.0));
    const double ang = (double)pos * inv;
    const double twopi = 6.283185307179586476925, hp = 1.5707963267948966192;
    const double r = ang - twopi * rint(ang / twopi);
    const double kq = rint(r / hp), t = r - kq * hp, t2 = t * t;
    double sp = 1.0 / 6227020800.0; sp = sp * t2 - 1.0 / 39916800.0; sp = sp * t2 + 1.0 / 362880.0; sp = sp * t2 - 1.0 / 5040.0; sp = sp * t2 + 1.0 / 120.0; sp = sp * t2 - 1.0 / 6.0; sp = sp * t2 + 1.0; sp *= t;
    double cp = -1.0 / 87178291200.0; cp = cp * t2 + 1.0 / 479001600.0; cp = cp * t2 - 1.0 / 3628800.0; cp = cp * t2 + 1.0 / 40320.0; cp = cp * t2 - 1.0 / 720.0; cp = cp * t2 + 1.0 / 24.0; cp = cp * t2 - 0.5; cp = cp * t2 + 1.0;
    const int qd = ((int)kq) & 3; double s, c;
    if (qd == 0) { s = sp; c = cp; } else if (qd == 1) { s = cp; c = -sp; } else if (qd == 2) { s = -sp; c = -cp; } else { s = -cp; c = sp; }
    co = (float)c; si = (float)s;
}
__device__ __forceinline__ void p0_prologue(Frame& F, const Args& A) {
    unsigned char* ws = A.ws;
    const float* x = A.in[0]; const float* even_norm = A.in[1]; const float* even_w_in = A.in[2]; const float* even_bf = A.in[3];
    const float* w_glu = A.in[12]; const float* even_w_out = A.in[14]; const float* odd_norm = A.in[15]; const float* odd_w_in = A.in[16]; const float* odd_w_out = A.in[18];
    const float* mlp_norm = A.in[19]; const float* w_up = A.in[20]; const float* w_dn = A.in[21];
    LAS float* scr = (LAS float*)(F.lds + RING_OFF + F.wave * 9216);
    LAS float* GWs = (LAS float*)(F.lds + RING_OFF + 98304);
    const int gw = F.vcu * NWAVES + F.wave, NGW = F.G * NWAVES;
    for (int i = F.tid; i < 8192; i += NWAVES * 64) { const int h = i >> 10, k = i & 1023; GWs[i] = even_norm[k] * even_w_in[(size_t)k * 2056 + 1536 + h]; }
    constexpr int NITEMS = 12160;
    const float C2 = 0.125f * LOG2E, KS = 0.08838834764831845f;
    for (int it = gw; it < NITEMS; it += NGW) {
        int r = it;
#define SEG(cnt, W, ldw, scol, K, ncols, WT, drow, gain, scale) if (r < (cnt)) { p0_transpose_item(W, ldw, scol, K, ncols, (bf16*)(ws + (WT)), drow, gain, scale, scr, r, F.lane); continue; } r -= (cnt);
        SEG(256, even_w_in, 2056, 0, 1024, 512, WS_WIN0, 0, even_norm, C2)
        SEG(512, even_w_in, 2056, 512, 1024, 1024, WS_WIN0, 512, even_norm, 1.0f)
        SEG(256, even_w_in, 2056, 1544, 1024, 512, WS_WIN0, 1536, even_norm, 1.0f)
        SEG(128, w_glu, 512, 0, 512, 512, WS_WGLU, 0, nullptr, 1.0f)
        SEG(512, even_w_out, 1024, 0, 1024, 1024, WS_WOUT0, 0, nullptr, 1.0f)
        SEG(2048, w_up, 4096, 0, 1024, 4096, WS_WUP0, 0, mlp_norm, 1.0f)
        SEG(2048, w_dn, 1024, 0, 4096, 1024, WS_WDN0, 0, nullptr, 1.0f)
        SEG(1024, odd_w_in, 3584, 0, 1024, 2048, WS_WIN1, 0, odd_norm, 1.0f)
        SEG(256, odd_w_in, 3584, 2048, 1024, 512, WS_WIN1, 2048, odd_norm, KS)
        SEG(512, odd_w_in, 3584, 2560, 1024, 1024, WS_WIN1, 2560, odd_norm, 1.0f)
        SEG(512, odd_w_out, 1024, 0, 1024, 1024, WS_WOUT1, 0, nullptr, 1.0f)
        SEG(2048, w_up + (size_t)1024 * 4096, 4096, 0, 1024, 4096, WS_WUP1, 0, mlp_norm + 1024, 1.0f)
        SEG(2048, w_dn + (size_t)4096 * 1024, 1024, 0, 4096, 1024, WS_WDN1, 0, nullptr, 1.0f)
#undef SEG
    }
    { float* rot = (float*)(ws + WS_ROT);
      for (int i = F.vcu * (NWAVES * 64) + F.tid; i < SEQ * 64; i += F.G * NWAVES * 64) { float c, s; rot_entry(i >> 6, i & 63, c, s); *(float2*)(rot + 2 * (size_t)i) = make_float2(c, s); } }
    LDS_WAIT(); __syncthreads();
    bf16* XB = (bf16*)(ws + WS_XB); float* SSP = (float*)(ws + WS_SSP); float* LOGF = (float*)(ws + WS_LOGF);
    for (int m = gw; m < MTOK; m += NGW) {
        const GAS f32x4* xr = (const GAS f32x4*)(x + (size_t)m * DM) + F.lane;
        f32x4 v[4]; float ss = 0.f;
#pragma unroll
        for (int j = 0; j < 4; ++j) { v[j] = xr[64 * j]; ss += (v[j].x * v[j].x + v[j].y * v[j].y) + (v[j].z * v[j].z + v[j].w * v[j].w); }
        GAS unsigned long long* o8 = (GAS unsigned long long*)(XB + (size_t)m * DM) + F.lane;
#pragma unroll
        for (int j = 0; j < 4; ++j) o8[64 * j] = (unsigned long long)pk2(v[j].x, v[j].y) | ((unsigned long long)pk2(v[j].z, v[j].w) << 32);
        float fa[8];
#pragma unroll
        for (int h = 0; h < 8; ++h) { float a = 0.f;
#pragma unroll
            for (int j = 0; j < 4; ++j) { const f32x4 g4 = *(const LAS f32x4*)(GWs + h * 1024 + 256 * j + 4 * F.lane); a += (v[j].x * g4.x + v[j].y * g4.y) + (v[j].z * g4.z + v[j].w * g4.w); }
            fa[h] = wave_sum(a); }
        ss = wave_sum(ss);
        const float rstd = 1.0f / sqrtf(ss * (1.0f / DM) + 1e-6f);
        float z = 0.f;
#pragma unroll
        for (int h = 0; h < 8; ++h) if (F.lane == h) z = fa[h];
        if (F.lane < 8) { z = z * rstd + even_bf[F.lane];
            const float r = (z > 0.f) ? -log1pf(expf(-z)) : (z - log1pf(expf(z)));
            LOGF[((size_t)((m >> 12) * 8 + F.lane)) * SEQ + (m & 4095)] = r; }
        if (F.lane == 0) SSP[(size_t)m * 16] = ss;
    }
}
__device__ __forceinline__ void p1_cumsum(Frame& F, const Args& A, int bh) {
    const float* src = (const float*)(A.ws + WS_LOGF) + (size_t)bh * SEQ + F.tid * 8;
    float* dst = (float*)(A.ws + WS_CB) + (size_t)bh * SEQ + F.tid * 8;
    LAS float* wsum = (LAS float*)(F.lds + RING_OFF);
    const f32x4 a = *(const f32x4*)src, b = *(const f32x4*)(src + 4);
    float v[8] = {a.x, a.y, a.z, a.w, b.x, b.y, b.z, b.w};
#pragma unroll
    for (int i = 1; i < 8; ++i) v[i] += v[i - 1];
    const float tot = v[7]; float inc = tot;
#pragma unroll
    for (int o = 1; o < 64; o <<= 1) { const float t = __shfl_up(inc, o); if (F.lane >= o) inc += t; }
    if (F.lane == 63) wsum[F.wave] = inc;
    LDS_WAIT(); __syncthreads();
    float base = inc - tot;
#pragma unroll
    for (int w = 0; w < NWAVES; ++w) if (w < F.wave) base += wsum[w];
    f32x4 o0, o1;
    o0.x = (v[0] + base) * LOG2E; o0.y = (v[1] + base) * LOG2E; o0.z = (v[2] + base) * LOG2E; o0.w = (v[3] + base) * LOG2E;
    o1.x = (v[4] + base) * LOG2E; o1.y = (v[5] + base) * LOG2E; o1.z = (v[6] + base) * LOG2E; o1.w = (v[7] + base) * LOG2E;
    *(f32x4*)dst = o0; *(f32x4*)(dst + 4) = o1;
    LDS_WAIT(); __syncthreads();
}
__device__ __forceinline__ void p_final(Frame& F, const Args& A) {
    const int gw = F.vcu * NWAVES + F.wave, NGW = F.G * NWAVES;
    const float* g = A.in[22];
    f32x4 gg[4];
#pragma unroll
    for (int j = 0; j < 4; ++j) gg[j] = ((const f32x4*)g)[F.lane + 64 * j];
    for (int m = gw; m < MTOK; m += NGW) {
        GAS f32x4* xr = (GAS f32x4*)(A.out + (size_t)m * DM) + F.lane;
        f32x4 v[4]; float ss = 0.f;
#pragma unroll
        for (int j = 0; j < 4; ++j) { v[j] = xr[64 * j]; ss += (v[j].x * v[j].x + v[j].y * v[j].y) + (v[j].z * v[j].z + v[j].w * v[j].w); }
        ss = wave_sum(ss);
        const float r = 1.0f / sqrtf(ss * (1.0f / DM) + 1e-6f);
#pragma unroll
        for (int j = 0; j < 4; ++j) xr[64 * j] = v[j] * r * gg[j];
    }
}


__device__ __forceinline__ float gelu_tanh_fast(float x) { const float u = 0.7978845608028654f * (x + 0.044715f * x * x * x); return x / (1.0f + __expf(-2.0f * u)); }
__device__ __forceinline__ void s5_lambar(float lr, float li, float dt, float& lbr, float& lbi) { const float er = expf(lr * dt); float sn, cs; sincosf(li * dt, &sn, &cs); lbr = er * cs; lbi = er * sn; }
template <bool PASS2>
__device__ __forceinline__ void s5_pass(const unsigned short* U, unsigned short* YG, size_t row0, int g, LAS float* BUs, LAS unsigned* Xs, const pg8::bf16x8 (&Bf)[8], const pg8::bf16x8 (&Cf)[4],
                                        float lbr, float lbi, float dsk, float& xr, float& xi, int lane) {
    typedef float f32x2 __attribute__((ext_vector_type(2)));
    const int c16 = lane & 15, kq = lane >> 4;
    const pg8::bf16x8 zero8 = {0, 0, 0, 0, 0, 0, 0, 0};
    pg8::bf16x8 an = zero8;
    if (kq < 2) an = *(const pg8::bf16x8*)(U + (row0 + c16) * 512 + g * 16 + 8 * kq);
    for (int sc = 0; sc < 32; ++sc) {
        const size_t r0 = row0 + 16 * sc;
        const pg8::bf16x8 a = an;
        if (sc + 1 < 32) { if (kq < 2) an = *(const pg8::bf16x8*)(U + (r0 + 16 + c16) * 512 + g * 16 + 8 * kq); }
#pragma unroll
        for (int nb = 0; nb < 8; ++nb) {
            pg8::f32x4 d = {0.f, 0.f, 0.f, 0.f};
            d = __builtin_amdgcn_mfma_f32_16x16x32_bf16(a, Bf[nb], d, 0, 0, 0);
#pragma unroll
            for (int r = 0; r < 4; ++r) BUs[(4 * kq + r) * 128 + 16 * nb + c16] = d[r];
        }
#pragma unroll
        for (int t = 0; t < 16; ++t) {
            const f32x2 bu = *(const LAS f32x2*)(BUs + t * 128 + 2 * lane);
            const float nxr = lbr * xr - lbi * xi + bu.x, nxi = lbr * xi + lbi * xr + bu.y;
            xr = nxr; xi = nxi;
            if (PASS2) Xs[t * 64 + lane] = pg8::cvt_pk_bf16(xr, xi);
        }
        if (PASS2) {
            pg8::f32x4 y = {0.f, 0.f, 0.f, 0.f};
#pragma unroll
            for (int ks = 0; ks < 4; ++ks) { const pg8::bf16x8 xa = *(const LAS pg8::bf16x8*)((const LAS unsigned short*)Xs + c16 * 128 + 32 * ks + 8 * kq); y = __builtin_amdgcn_mfma_f32_16x16x32_bf16(xa, Cf[ks], y, 0, 0, 0); }
#pragma unroll
            for (int r = 0; r < 4; ++r) { const size_t m = r0 + 4 * kq + r; const float uv = bf2f(U[m * 512 + g * 16 + c16]); YG[m * 512 + g * 16 + c16] = (unsigned short)f2bf(gelu_tanh_fast(y[r] + dsk * uv)); }
        }
    }
}
__device__ __forceinline__ void s5_unit(Frame& F, const Args& A, int b, int g) {
    typedef float f32x2 __attribute__((ext_vector_type(2)));
    const int lane = F.lane, w = F.wave, c16 = lane & 15, kq = lane >> 4;
    const float* log_dt = A.in[4]; const float* lam_re = A.in[5]; const float* lam_im = A.in[6]; const float* b_re = A.in[7]; const float* b_im = A.in[8];
    const float* c_re = A.in[9]; const float* c_im = A.in[10]; const float* d_skip = A.in[11];
    const unsigned short* U = (const unsigned short*)(A.ws + WS_U); unsigned short* YG = (unsigned short*)(A.ws + WS_YG);
    LAS float* BUs = (LAS float*)(F.lds + RING_OFF + w * 12288);
    LAS unsigned* Xs = (LAS unsigned*)(F.lds + RING_OFF + w * 12288 + 8192);
    LAS f32x2* Es = (LAS f32x2*)(F.lds + RING_OFF + 98304);
    const float dt = expf(log_dt[g]);
    float lbr, lbi; s5_lambar(lam_re[g * 64 + lane], lam_im[g * 64 + lane], dt, lbr, lbi);
    pg8::bf16x8 Bf[8], Cf[4];
#pragma unroll
    for (int nb = 0; nb < 8; ++nb) {
        const int comp = 16 * nb + c16, pp = comp >> 1, im = comp & 1;
        const float lr = lam_re[g * 64 + pp], li = lam_im[g * 64 + pp]; float pr, pi; s5_lambar(lr, li, dt, pr, pi);
        const float nr = pr - 1.0f, ni = pi, den = lr * lr + li * li, cr = (nr * lr + ni * li) / den, ci = (ni * lr - nr * li) / den;
#pragma unroll
        for (int j = 0; j < 8; ++j) { float val = 0.f;
            if (kq < 2) { const int h = 8 * kq + j; const float br = b_re[(g * 64 + pp) * 16 + h], bi = b_im[(g * 64 + pp) * 16 + h]; val = im ? (cr * bi + ci * br) : (cr * br - ci * bi); }
            Bf[nb][j] = (short)f2bf(val); }
    }
#pragma unroll
    for (int ks = 0; ks < 4; ++ks)
#pragma unroll
        for (int j = 0; j < 8; ++j) { const int comp = 32 * ks + 8 * kq + j, pp = comp >> 1, im = comp & 1;
            const float val = im ? -c_im[(g * 16 + c16) * 64 + pp] : c_re[(g * 16 + c16) * 64 + pp]; Cf[ks][j] = (short)f2bf(val); }
    const float dsk = d_skip[g * 16 + c16];
    const size_t row0 = (size_t)b * SEQ + (size_t)w * 512;
    float xr = 0.f, xi = 0.f;
    s5_pass<false>(U, YG, row0, g, BUs, Xs, Bf, Cf, lbr, lbi, dsk, xr, xi, lane);
    Es[w * 64 + lane] = (f32x2){xr, xi};
    LDS_WAIT(); __syncthreads();
    float pr = lbr, pi = lbi;
#pragma unroll
    for (int i = 0; i < 9; ++i) { const float t = pr * pr - pi * pi; pi = 2.0f * pr * pi; pr = t; }
    xr = 0.f; xi = 0.f;
    for (int v = 0; v < w; ++v) { const f32x2 e = Es[v * 64 + lane]; const float nr = pr * xr - pi * xi + e.x, ni = pr * xi + pi * xr + e.y; xr = nr; xi = ni; }
    s5_pass<true>(U, YG, row0, g, BUs, Xs, Bf, Cf, lbr, lbi, dsk, xr, xi, lane);
    LDS_WAIT(); __syncthreads();
}

typedef float f32x16 __attribute__((ext_vector_type(16)));
constexpr int RT_PITCH = 136;
__device__ __forceinline__ int crow16(int r, int hi) { return (r & 3) + 8 * (r >> 2) + 4 * hi; }
__device__ __forceinline__ float ret_log2gamma(int h) { return log2f(1.0f - exp2f(-5.0f - (float)h)); }
__device__ __forceinline__ pg8::bf16x8 gather8(const LAS unsigned short* p, int o0, int o1, int o2, int o3, int o4, int o5, int o6, int o7) {
    pg8::bf16x8 f; f[0] = (short)p[o0]; f[1] = (short)p[o1]; f[2] = (short)p[o2]; f[3] = (short)p[o3]; f[4] = (short)p[o4]; f[5] = (short)p[o5]; f[6] = (short)p[o6]; f[7] = (short)p[o7]; return f; }

__device__ __forceinline__ void conv_phase(Frame& F, const Args& A) {
    const unsigned short* HC = (const unsigned short*)(A.ws + WS_P1); const unsigned short* GB = HC + P1_STRIDE; const unsigned short* GC = HC + 2 * P1_STRIDE;
    unsigned short* MIX1 = (unsigned short*)(A.ws + WS_MIX1); const float* cw = A.in[17];
    for (int it = F.vcu * (NWAVES * 64) + F.tid; it < (MTOK / 16) * 64; it += F.G * NWAVES * 64) {
        const int cg = it & 63, run = it >> 6, c0 = cg * 8; const size_t m0 = (size_t)run * 16; const int l0 = (int)(m0 & 4095);
        float w0[8], w1[8], w2[8], z1[8], z2[8];
#pragma unroll
        for (int e = 0; e < 8; ++e) { w0[e] = cw[c0 + e]; w1[e] = cw[512 + c0 + e]; w2[e] = cw[1024 + c0 + e]; z1[e] = 0.f; z2[e] = 0.f; }
        if (l0 > 0) {
            const v4u h1 = *(const v4u*)(HC + (m0 - 1) * 512 + c0), g1 = *(const v4u*)(GC + (m0 - 1) * 512 + c0), h2 = *(const v4u*)(HC + (m0 - 2) * 512 + c0), g2 = *(const v4u*)(GC + (m0 - 2) * 512 + c0);
#pragma unroll
            for (int e = 0; e < 4; ++e) { z1[2 * e] = __uint_as_float(h1[e] << 16) * __uint_as_float(g1[e] << 16); z1[2 * e + 1] = __uint_as_float(h1[e] & 0xffff0000u) * __uint_as_float(g1[e] & 0xffff0000u);
                z2[2 * e] = __uint_as_float(h2[e] << 16) * __uint_as_float(g2[e] << 16); z2[2 * e + 1] = __uint_as_float(h2[e] & 0xffff0000u) * __uint_as_float(g2[e] & 0xffff0000u); }
        }
        for (int t = 0; t < 16; ++t) {
            const size_t m = m0 + t;
            const v4u hh = *(const v4u*)(HC + m * 512 + c0), gc = *(const v4u*)(GC + m * 512 + c0), gb = *(const v4u*)(GB + m * 512 + c0);
            float z[8], o[8];
#pragma unroll
            for (int e = 0; e < 4; ++e) { z[2 * e] = __uint_as_float(hh[e] << 16) * __uint_as_float(gc[e] << 16); z[2 * e + 1] = __uint_as_float(hh[e] & 0xffff0000u) * __uint_as_float(gc[e] & 0xffff0000u); }
#pragma unroll
            for (int e = 0; e < 8; ++e) { const float y = w0[e] * z2[e] + w1[e] * z1[e] + w2[e] * z[e]; const float gbv = (e & 1) ? __uint_as_float(gb[e >> 1] & 0xffff0000u) : __uint_as_float(gb[e >> 1] << 16); o[e] = gbv * y; z2[e] = z1[e]; z1[e] = z[e]; }
            v4u ow; ow.x = pk2(o[0], o[1]); ow.y = pk2(o[2], o[3]); ow.z = pk2(o[4], o[5]); ow.w = pk2(o[6], o[7]);
            *(v4u*)(MIX1 + m * 1024 + c0) = ow;
        }
    }
}
__device__ __forceinline__ void ret_stage_tile(Frame& F, const unsigned short* src, size_t t0, int col0, LAS unsigned short* dst, bool decay, float lg) {
#pragma unroll
    for (int i = 0; i < 4; ++i) { const int f = F.tid + 512 * i, row = f >> 4, cq = (f & 15) * 8;
        v4u v = *(const v4u*)(src + (t0 + row) * 512 + col0 + cq);
        if (decay) { const float s = exp2f(lg * (float)(127 - row));
#pragma unroll
            for (int e = 0; e < 4; ++e) v[e] = pk2(__uint_as_float(v[e] << 16) * s, __uint_as_float(v[e] & 0xffff0000u) * s); }
        *(LAS v4u*)(dst + row * RT_PITCH + cq) = v; }
}
__device__ __forceinline__ void ret_kv_unit(Frame& F, const Args& A, int u) {
    const int b = u >> 5, h = (u >> 3) & 3, a = u & 7, lane = F.lane, w = F.wave, l31 = lane & 31, hi = lane >> 5;
    const unsigned short* RK = (const unsigned short*)(A.ws + WS_P1) + 4 * P1_STRIDE; const unsigned short* RV = (const unsigned short*)(A.ws + WS_P1) + 5 * P1_STRIDE;
    float* PT = (float*)(A.ws + WS_KV) + (size_t)u * 4 * 16384;
    LAS unsigned short* Ks = (LAS unsigned short*)(F.lds + RING_OFF); LAS unsigned short* Vs = Ks + 128 * RT_PITCH;
    const float lg = ret_log2gamma(h), g128 = exp2f(lg * 128.0f);
    const int vb = w >> 1, db0 = 2 * (w & 1);
    f32x16 acc[2]; acc[0] = f32x16{}; acc[1] = f32x16{};
    for (int r = 0; r < 4; ++r) {
        const size_t t0 = (size_t)b * SEQ + (size_t)(4 * a + r) * 128;
        __syncthreads();
        ret_stage_tile(F, RK, t0, h * 128, Ks, true, lg); ret_stage_tile(F, RV, t0, h * 128, Vs, false, 0.f);
        LDS_WAIT(); __syncthreads();
        if (r > 0) {
#pragma unroll
            for (int j = 0; j < 2; ++j)
#pragma unroll
                for (int q = 0; q < 16; ++q) PT[(size_t)r * 16384 + (vb * 32 + crow16(q, hi)) * 128 + (db0 + j) * 32 + l31] = acc[j][q];
        }
#pragma unroll
        for (int j = 0; j < 2; ++j) acc[j] = acc[j] * g128;
#pragma unroll
        for (int ks = 0; ks < 8; ++ks) {
            const int tk = 16 * ks + 8 * hi;
            const LAS unsigned short* vp = Vs + tk * RT_PITCH + vb * 32 + l31;
            const pg8::bf16x8 af = gather8(vp, 0, RT_PITCH, 2 * RT_PITCH, 3 * RT_PITCH, 4 * RT_PITCH, 5 * RT_PITCH, 6 * RT_PITCH, 7 * RT_PITCH);
#pragma unroll
            for (int j = 0; j < 2; ++j) { const LAS unsigned short* kp = Ks + tk * RT_PITCH + (db0 + j) * 32 + l31;
                const pg8::bf16x8 bfr = gather8(kp, 0, RT_PITCH, 2 * RT_PITCH, 3 * RT_PITCH, 4 * RT_PITCH, 5 * RT_PITCH, 6 * RT_PITCH, 7 * RT_PITCH);
                acc[j] = __builtin_amdgcn_mfma_f32_32x32x16_bf16(af, bfr, acc[j], 0, 0, 0); }
        }
    }
#pragma unroll
    for (int j = 0; j < 2; ++j)
#pragma unroll
        for (int q = 0; q < 16; ++q) PT[(vb * 32 + crow16(q, hi)) * 128 + (db0 + j) * 32 + l31] = acc[j][q];
    __syncthreads();
}
__device__ __forceinline__ void ret_out_unit(Frame& F, const Args& A, int u) {
    const int b = u >> 7, h = (u >> 5) & 3, i = u & 31, a = i >> 2, r = i & 3, lane = F.lane, w = F.wave, l31 = lane & 31, hi = lane >> 5;
    const unsigned short* RQ = (const unsigned short*)(A.ws + WS_P1) + 3 * P1_STRIDE; const unsigned short* RK = RQ + P1_STRIDE; const unsigned short* RV = RQ + 2 * P1_STRIDE; const unsigned short* RG = RQ + 3 * P1_STRIDE;
    unsigned short* MIX1 = (unsigned short*)(A.ws + WS_MIX1);
    const float* PTg = (const float*)(A.ws + WS_KV) + (size_t)((b * 4 + h) * 8) * 4 * 16384;
    LAS unsigned short* Ss = (LAS unsigned short*)(F.lds + RING_OFF); LAS unsigned short* Vs = Ss + 128 * RT_PITCH; LAS float* GN = (LAS float*)(F.lds + RING_OFF + 2 * 128 * RT_PITCH * 2);
    const float lg = ret_log2gamma(h);
    const size_t t0 = (size_t)b * SEQ + (size_t)i * 128;
    __syncthreads();
    { const float gr = exp2f(lg * 128.0f * (float)r);
      for (int k = 0; k < 32; ++k) { const int e = F.tid + 512 * k; float s = 0.f;
          for (int ap = 0; ap < a; ++ap) s += exp2f(lg * 512.0f * (float)(a - 1 - ap)) * PTg[(size_t)ap * 4 * 16384 + e];
          s *= gr;
          if (r > 0) s += PTg[(size_t)a * 4 * 16384 + (size_t)r * 16384 + e];
          Ss[(e >> 7) * RT_PITCH + (e & 127)] = (unsigned short)f2bf(s); } }
    ret_stage_tile(F, RV, t0, h * 128, Vs, false, 0.f);
    LDS_WAIT(); __syncthreads();
    const int qb = w & 3, vh = w >> 2;
    pg8::bf16x8 qf[8];
#pragma unroll
    for (int ks = 0; ks < 8; ++ks) qf[ks] = *(const pg8::bf16x8*)(RQ + (t0 + 32 * qb + l31) * 512 + h * 128 + 16 * ks + 8 * hi);
    f32x16 inner[2], cross[2]; inner[0] = f32x16{}; inner[1] = f32x16{}; cross[0] = f32x16{}; cross[1] = f32x16{};
    const int qpos = 32 * qb + l31;
    for (int sb = 0; sb <= qb; ++sb) {
        f32x16 st = f32x16{};
#pragma unroll
        for (int ks = 0; ks < 8; ++ks) { const pg8::bf16x8 kf = *(const pg8::bf16x8*)(RK + (t0 + 32 * sb + l31) * 512 + h * 128 + 16 * ks + 8 * hi); st = __builtin_amdgcn_mfma_f32_32x32x16_bf16(kf, qf[ks], st, 0, 0, 0); }
#pragma unroll
        for (int q = 0; q < 16; ++q) { const int sp = 32 * sb + crow16(q, hi); const int dlt = qpos - sp; st[q] = (dlt >= 0) ? st[q] * exp2f(lg * (float)dlt) : 0.f; }
#pragma unroll
        for (int s2 = 0; s2 < 2; ++s2) {
            pg8::bf16x8 af;
#pragma unroll
            for (int j = 0; j < 8; ++j) af[j] = (short)f2bf(st[8 * s2 + j]);
            const int srow = 32 * sb + 16 * s2 + 4 * hi;
#pragma unroll
            for (int j = 0; j < 2; ++j) { const LAS unsigned short* vp = Vs + srow * RT_PITCH + vh * 64 + j * 32 + l31;
                const pg8::bf16x8 bfr = gather8(vp, 0, RT_PITCH, 2 * RT_PITCH, 3 * RT_PITCH, 8 * RT_PITCH, 9 * RT_PITCH, 10 * RT_PITCH, 11 * RT_PITCH);
                inner[j] = __builtin_amdgcn_mfma_f32_32x32x16_bf16(af, bfr, inner[j], 0, 0, 0); }
        }
    }
#pragma unroll
    for (int ks = 0; ks < 8; ++ks)
#pragma unroll
        for (int j = 0; j < 2; ++j) { const pg8::bf16x8 sf = *(const LAS pg8::bf16x8*)(Ss + (vh * 64 + j * 32 + l31) * RT_PITCH + 16 * ks + 8 * hi); cross[j] = __builtin_amdgcn_mfma_f32_32x32x16_bf16(qf[ks], sf, cross[j], 0, 0, 0); }
    float sum[16], ssq[16];
#pragma unroll
    for (int e = 0; e < 16; ++e) { const float qd = exp2f(lg * (float)(32 * qb + crow16(e, hi) + 1));
        const float o0 = inner[0][e] + qd * cross[0][e], o1 = inner[1][e] + qd * cross[1][e]; inner[0][e] = o0; inner[1][e] = o1;
        float s = o0 + o1, q2 = o0 * o0 + o1 * o1;
#pragma unroll
        for (int o = 1; o < 32; o <<= 1) { s += __shfl_xor(s, o); q2 += __shfl_xor(q2, o); }
        sum[e] = s; ssq[e] = q2; }
    if (l31 == 0) {
#pragma unroll
        for (int e = 0; e < 16; ++e) { const int ql = 32 * qb + crow16(e, hi); GN[(ql * 2 + vh) * 2] = sum[e]; GN[(ql * 2 + vh) * 2 + 1] = ssq[e]; }
    }
    LDS_WAIT(); __syncthreads();
#pragma unroll
    for (int e = 0; e < 16; ++e) { const int ql = 32 * qb + crow16(e, hi);
        const float s = GN[ql * 4] + GN[ql * 4 + 2], q2 = GN[ql * 4 + 1] + GN[ql * 4 + 3];
        const float mu = s * (1.0f / 128.0f), var = fmaxf(q2 * (1.0f / 128.0f) - mu * mu, 0.f), rs = 1.0f / sqrtf(var + 1e-6f);
        const size_t m = t0 + ql;
#pragma unroll
        for (int j = 0; j < 2; ++j) { const int col = h * 128 + vh * 64 + j * 32 + l31; const float gv = bf2f(RG[m * 512 + col]);
            MIX1[m * 1024 + 512 + col] = (unsigned short)f2bf((gv / (1.0f + __expf(-gv))) * (inner[j][e] - mu) * rs); } }
    __syncthreads();
}
__global__ void __launch_bounds__(NWAVES * 64, 2) mk_fwd(Args args) {
    extern __shared__ __attribute__((aligned(16))) unsigned char lds[];
    Frame F;
    F.lds = (LAS unsigned char*)lds;
    F.MISC = (volatile LAS unsigned*)(F.lds + MISC_OFF);
    F.tid = threadIdx.x; F.lane = F.tid & 63; F.wave = __builtin_amdgcn_readfirstlane(F.tid >> 6);
    F.G = gridDim.x; { const int bx = blockIdx.x; F.vcu = (F.G % 8 == 0) ? (bx % 8) * (F.G / 8) + bx / 8 : bx; }
    unsigned char* ws = args.ws;
    F.ctl = (gu32*)(ws + WS_CTL);
    for (int u = F.tid; u < (LDS_BYTES - LDSCTL_OFF) / 4; u += NWAVES * 64) ((LAS unsigned*)(F.lds + LDSCTL_OFF))[u] = 0u;
    __syncthreads();
    const int lo = args.ph_lo, hi = args.ph_hi;
    const bool single = (hi - lo) > 1;
    XcdBarrier bar; bar.bar = (unsigned*)(F.ctl + CW_BAR) + args.li * XCD_BAR_WORDS; bar.x = 0; bar.st = nullptr;
    if (single) bar = xcd_barrier_post((unsigned*)(F.ctl + CW_BAR) + args.li * XCD_BAR_WORDS, F.MISC + 8);
#define IN(k) (lo <= (k) && (k) < hi)
#define BOTH(k) (IN(k) && IN((k) + 1))
#define GRID_BAR() xcd_barrier(bar)
    pg8::bf16_t* XB = (pg8::bf16_t*)(ws + WS_XB);
    float* SSP = (float*)(ws + WS_SSP);
    const float* ROT = (const float*)(ws + WS_ROT);

    if (IN(0)) { p0_prologue(F, args); if (BOTH(0)) GRID_BAR(); }

    if (IN(1)) {
        if (blockIdx.x < 64) p1_cumsum(F, args, (int)blockIdx.x);
        pg8::Gemm g{XB, (const pg8::bf16_t*)(ws + WS_WIN0), MTOK, 2048, DM}; pg8::StaticOrder S; S.init(MTOK, 2048, F.G, (int)blockIdx.x);
        pg8::EpiRsBf16<0, false> E{(pg8::bf16_t*)(ws + WS_Q), 512, 2, (size_t)(16 * MiB), SSP, 1, nullptr, 0, 0};
        pg8::gemm_phase<pg8::EpiRsBf16<0, false>, pg8::StaticOrder, true, true>(F.lds + RING_OFF, g, S, E);
        if (BOTH(1)) GRID_BAR();
    }
    if (IN(2)) {
        for (int u = F.vcu; u < 256; u += F.G) s5_unit(F, args, u >> 5, u & 31);
        const attn_body::AttnTensors AT{(const attn_body::bf16*)(ws + WS_Q), (const attn_body::bf16*)(ws + WS_K), (const attn_body::bf16*)(ws + WS_V), (attn_body::bf16*)(ws + WS_MIX), (const float*)(ws + WS_CB)};
        const attn_body::StaticOrder S((int)F.G, (int)blockIdx.x);
        attn_body::attn_phase<attn_body::StaticOrder>((char*)lds + RING_OFF, AT, S);
        if (BOTH(2)) GRID_BAR();
    }
    if (IN(3)) {
        pg8::Gemm g{(const pg8::bf16_t*)(ws + WS_YG), (const pg8::bf16_t*)(ws + WS_WGLU), MTOK, 512, 512}; pg8::StaticOrder S; S.init(MTOK, 512, F.G, (int)blockIdx.x);
        pg8::EpiGlu E{(const pg8::bf16_t*)(ws + WS_YG), 512, args.in[13], (pg8::bf16_t*)(ws + WS_MIX), 1024, 512};
        pg8::gemm_phase<pg8::EpiGlu, pg8::StaticOrder, true, true>(F.lds + RING_OFF, g, S, E);
        if (BOTH(3)) GRID_BAR();
    }
    if (IN(4)) {
        pg8::Gemm g{(const pg8::bf16_t*)(ws + WS_MIX), (const pg8::bf16_t*)(ws + WS_WOUT0), MTOK, DM, DM}; pg8::StaticOrder S; S.init(MTOK, DM, F.G, (int)blockIdx.x);
        pg8::EpiResid<true> E{args.in[0], args.out, XB, SSP, DM};
        pg8::gemm_phase<pg8::EpiResid<true>, pg8::StaticOrder, true, true>(F.lds + RING_OFF, g, S, E);
        if (BOTH(4)) GRID_BAR();
    }
    if (IN(5)) {
        pg8::Gemm g{XB, (const pg8::bf16_t*)(ws + WS_WUP0), MTOK, DFF, DM}; pg8::StaticOrder S; S.init(MTOK, DFF, F.G, (int)blockIdx.x);
        pg8::EpiRsBf16<1, false> E{(pg8::bf16_t*)(ws + WS_BIG), DFF, 0, 0, SSP, 16, nullptr, 0, 0};
        pg8::gemm_phase<pg8::EpiRsBf16<1, false>, pg8::StaticOrder, true, true>(F.lds + RING_OFF, g, S, E);
        if (BOTH(5)) GRID_BAR();
    }
    if (IN(6)) {
        pg8::Gemm g{(const pg8::bf16_t*)(ws + WS_BIG), (const pg8::bf16_t*)(ws + WS_WDN0), MTOK, DM, DFF}; pg8::StaticOrder S; S.init(MTOK, DM, F.G, (int)blockIdx.x);
        pg8::EpiResid<true> E{args.out, args.out, XB, SSP, DM};
        pg8::gemm_phase<pg8::EpiResid<true>, pg8::StaticOrder, true, true>(F.lds + RING_OFF, g, S, E);
        if (BOTH(6)) GRID_BAR();
    }
    if (IN(7)) {
        pg8::Gemm g{XB, (const pg8::bf16_t*)(ws + WS_WIN1), MTOK, 3584, DM}; pg8::StaticOrder S; S.init(MTOK, 3584, F.G, (int)blockIdx.x);
        pg8::EpiRsBf16<0, true> E{(pg8::bf16_t*)(ws + WS_P1), 512, 2, (size_t)(16 * MiB), SSP, 16, ROT, 6, 10};
        pg8::gemm_phase<pg8::EpiRsBf16<0, true>, pg8::StaticOrder, true, true>(F.lds + RING_OFF, g, S, E);
        if (BOTH(7)) GRID_BAR();
    }
    if (IN(8)) {
        conv_phase(F, args);
        for (int u = F.vcu; u < 256; u += F.G) ret_kv_unit(F, args, u);
        if (BOTH(8)) GRID_BAR();
    }
    if (IN(9)) {
        const int per = 1024 / F.G;
        for (int k = 0; k < per; ++k) ret_out_unit(F, args, F.vcu * per + k);
        if (BOTH(9)) GRID_BAR();
    }
    if (IN(10)) {
        pg8::Gemm g{(const pg8::bf16_t*)(ws + WS_MIX1), (const pg8::bf16_t*)(ws + WS_WOUT1), MTOK, DM, DM}; pg8::StaticOrder S; S.init(MTOK, DM, F.G, (int)blockIdx.x);
        pg8::EpiResid<true> E{args.out, args.out, XB, SSP, DM};
        pg8::gemm_phase<pg8::EpiResid<true>, pg8::StaticOrder, true, true>(F.lds + RING_OFF, g, S, E);
        if (BOTH(10)) GRID_BAR();
    }
    if (IN(11)) {
        pg8::Gemm g{XB, (const pg8::bf16_t*)(ws + WS_WUP1), MTOK, DFF, DM}; pg8::StaticOrder S; S.init(MTOK, DFF, F.G, (int)blockIdx.x);
        pg8::EpiRsBf16<1, false> E{(pg8::bf16_t*)(ws + WS_BIG), DFF, 0, 0, SSP, 16, nullptr, 0, 0};
        pg8::gemm_phase<pg8::EpiRsBf16<1, false>, pg8::StaticOrder, true, true>(F.lds + RING_OFF, g, S, E);
        if (BOTH(11)) GRID_BAR();
    }
    if (IN(12)) {
        pg8::Gemm g{(const pg8::bf16_t*)(ws + WS_BIG), (const pg8::bf16_t*)(ws + WS_WDN1), MTOK, DM, DFF}; pg8::StaticOrder S; S.init(MTOK, DM, F.G, (int)blockIdx.x);
        pg8::EpiResid<false> E{args.out, args.out, XB, SSP, DM};
        pg8::gemm_phase<pg8::EpiResid<false>, pg8::StaticOrder, true, true>(F.lds + RING_OFF, g, S, E);
        if (BOTH(12)) GRID_BAR();
    }
    if (IN(13)) p_final(F, args);
#undef IN
#undef BOTH
#undef GRID_BAR
}
extern "C" void kernel_launch(void* const* d_in, const int* in_sizes, int n_in, void* d_out, int out_size, void* d_ws, size_t ws_size, hipStream_t stream) {
    static int grid = 0;
    if (grid == 0) {
        if (n_in != 23 || out_size != MTOK * DM || ws_size < WS_END) { fprintf(stderr, "kernel_launch: unexpected problem: n_in %d out %d ws %zu\n", n_in, out_size, ws_size); grid = -1; return; }
        int dev = 0, cus = 0;
        if (hipGetDevice(&dev) != hipSuccess || hipDeviceGetAttribute(&cus, hipDeviceAttributeMultiprocessorCount, dev) != hipSuccess) { grid = -1; return; }
        if (hipFuncSetAttribute((const void*)mk_fwd, hipFuncAttributeMaxDynamicSharedMemorySize, LDS_BYTES) != hipSuccess) { fprintf(stderr, "kernel_launch: hipFuncSetAttribute failed\n"); grid = -1; return; }
        (void)hipGetLastError();
        grid = cus;
    }
    if (grid < 0) return;
    (void)hipMemsetAsync((char*)d_ws + WS_CTL, 0, CTL_ZERO_BYTES, stream);
    Args a{};
    for (int i = 0; i < 23; ++i) a.in[i] = (const float*)d_in[i];
    a.out = (float*)d_out; a.ws = (unsigned char*)d_ws;
    unsigned char* ws = (unsigned char*)d_ws;
    int nl = 0;
    auto run = [&](int lo, int hi) { a.ph_lo = lo; a.ph_hi = hi; a.li = nl++; hipLaunchKernelGGL(mk_fwd, dim3(grid), dim3(NWAVES * 64), LDS_BYTES, stream, a); };
    typedef unsigned short b16;
    run(0, 14);
}
```

```cpp
#include <hip/hip_runtime.h>
#include <hip/hip_bf16.h>
#include <cstdio>
#include <cstdint>
#include <cmath>
namespace pg8 {
#define PG8_LAS __attribute__((address_space(3)))
typedef unsigned short bf16_t;
typedef short bf16x8 __attribute__((ext_vector_type(8)));
typedef float f32x4 __attribute__((ext_vector_type(4)));
typedef unsigned u32x4 __attribute__((ext_vector_type(4)));
constexpr int BM = 256, BK = 64, HALF = 128, HTB = HALF * BK * 2  , STAGE_BYTES = 8 * HTB, NXCD = 8, WGM = 8;

__host__ __device__ __forceinline__ int lds_byte(int r, int c) { const int st = (r >> 4) * 2 + (c >> 5), rr = r & 15, cc = c & 31, ob = rr * 64 + cc * 2; return st * 1024 + (ob ^ (((ob >> 9) & 1) << 5)); }
__host__ __device__ __forceinline__ void stage_rc(int b, int& R, int& C) { const int st = b / 1024, sb = b % 1024, swz = sb ^ (((sb >> 9) & 1) << 5); R = (st >> 1) * 16 + swz / 64; C = (st & 1) * 32 + (swz % 64) / 2; }
__host__ __device__ __forceinline__ int perm32(int rho) { const int n = rho >> 4, i = rho & 15; return 8 * (i >> 2) + 4 * n + (i & 3); }

struct Unit { int pm, pn; };
struct Gemm { const bf16_t* A; const bf16_t* Bt; int M, N, K; };

struct StaticOrder {
    int nM, nN, nwg, G, c;
    __host__ __device__ void init(int M, int N, int G_, int c_) { nM = M / BM; nN = N / BM; nwg = nM * nN; G = G_; c = c_; }
    __host__ __device__ bool next(int i, Unit& u) const {
        const long L = (long)i * G + c; if (L >= nwg) return false;
        int wgid = (int)L; { const int q = nwg / NXCD, r = nwg % NXCD, xcd = wgid % NXCD, off = wgid / NXCD; wgid = (xcd < r ? xcd * (q + 1) : r * (q + 1) + (xcd - r) * q) + off; }
        const int nig = WGM * nN, gid = wgid / nig, fm = gid * WGM, gsz = (nM - fm) < WGM ? (nM - fm) : WGM;
        u.pm = fm + ((wgid % nig) % gsz); u.pn = (wgid % nig) / gsz; return true;
    }
    __device__ __forceinline__ void a_ready(const Unit&) const {}
    __device__ __forceinline__ void done(const Unit&) const {}
};

__device__ __forceinline__ unsigned cvt_pk_bf16(float lo, float hi) { unsigned r; asm volatile("v_cvt_pk_bf16_f32 %0, %1, %2" : "=v"(r) : "v"(lo), "v"(hi)); return r; }
typedef float f32x2 __attribute__((ext_vector_type(2)));
typedef unsigned u32x2 __attribute__((ext_vector_type(2)));
constexpr float RMS_EPS = 1e-6f;
__device__ __forceinline__ float row_rstd(const float* ssp, int nparts, int row) {
    const float* p = ssp + (size_t)row * 16; float s;
    if (nparts == 1) s = p[0];
    else { const f32x4 a = *(const f32x4*)p, b = *(const f32x4*)(p + 4), c = *(const f32x4*)(p + 8), d = *(const f32x4*)(p + 12);
        s = ((a[0] + a[1]) + (a[2] + a[3])) + ((b[0] + b[1]) + (b[2] + b[3])) + ((c[0] + c[1]) + (c[2] + c[3])) + ((d[0] + d[1]) + (d[2] + d[3])); }
    return 1.0f / sqrtf(s * (1.0f / 1024.0f) + RMS_EPS);
}
template <int ACT  , bool ROT>
struct EpiRsBf16 {
    static constexpr bool PERM = true, AFTER_DRAIN = false;
    bf16_t* O; int ldc; int tps; size_t split_stride; const float* ssp; int nparts; const float* rot; int rot_lo, rot_hi;
    __device__ __forceinline__ void operator()(const f32x4 (&acc)[2][2][4][2], const Unit& u, int wr, int wc, int fr, int fq) const {
        const int row0 = u.pm * BM + wr * 64 + fr;
        int colt = u.pn * BM; bf16_t* base = O;
        if (tps) { const int t = u.pn / tps; base += (size_t)t * split_stride; colt = (u.pn - t * tps) * BM; }
        const int col0 = colt + wc * 32 + 8 * fq;
        const bool dorot = ROT && (u.pn >= rot_lo) && (u.pn < rot_hi);
#pragma unroll
        for (int ai = 0; ai < 2; ++ai)
#pragma unroll
            for (int m = 0; m < 4; ++m) {
                const int row = row0 + ai * HALF + m * 16;
                const float rs = row_rstd(ssp, nparts, row);
                bf16_t* rowp = base + (size_t)row * ldc + col0;
                f32x4 c01 = {1.f, 0.f, 1.f, 0.f}, c23 = {1.f, 0.f, 1.f, 0.f};
                if (ROT) { if (dorot) { const float* tp = rot + ((size_t)(row & 4095) * 64 + wc * 16 + 4 * fq) * 2; c01 = *(const f32x4*)tp; c23 = *(const f32x4*)(tp + 4); } }
#pragma unroll
                for (int bj = 0; bj < 2; ++bj) {
                    f32x4 v0 = acc[ai][bj][m][0] * rs, v1 = acc[ai][bj][m][1] * rs;
                    if (ACT == 1) {
#pragma unroll
                        for (int j = 0; j < 4; ++j) { const float a = v0[j] > 0.f ? v0[j] : 0.f, b = v1[j] > 0.f ? v1[j] : 0.f; v0[j] = a * a; v1[j] = b * b; }
                    }
                    if (ROT) {
                        const f32x4 a0 = v0, a1 = v1;
                        v0[0] = a0[0] * c01[0] - a0[1] * c01[1]; v0[1] = a0[0] * c01[1] + a0[1] * c01[0];
                        v0[2] = a0[2] * c01[2] - a0[3] * c01[3]; v0[3] = a0[2] * c01[3] + a0[3] * c01[2];
                        v1[0] = a1[0] * c23[0] - a1[1] * c23[1]; v1[1] = a1[0] * c23[1] + a1[1] * c23[0];
                        v1[2] = a1[2] * c23[2] - a1[3] * c23[3]; v1[3] = a1[2] * c23[3] + a1[3] * c23[2];
                    }
                    u32x4 w; w.x = cvt_pk_bf16(v0[0], v0[1]); w.y = cvt_pk_bf16(v0[2], v0[3]); w.z = cvt_pk_bf16(v1[0], v1[1]); w.w = cvt_pk_bf16(v1[2], v1[3]);
                    *(u32x4*)(rowp + bj * HALF) = w;
                }
            }
    }
};
template <bool RES_BF16>
struct EpiResid {
    static constexpr bool PERM = false, AFTER_DRAIN = false;
    const float* resid_f; const bf16_t* resid_b; bf16_t* xb; float* ssp; int ldc;
    __device__ __forceinline__ void operator()(const f32x4 (&acc)[2][2][4][2], const Unit& u, int wr, int wc, int fr, int fq) const {
        const int col0 = u.pn * BM + wc * 32 + 4 * fq;
#pragma unroll
        for (int ai = 0; ai < 2; ++ai)
#pragma unroll
            for (int m = 0; m < 4; ++m) {
                const int row = u.pm * BM + ai * HALF + wr * 64 + m * 16 + fr; const size_t off = (size_t)row * ldc + col0; float ss = 0.f;
                f32x4 r[2][2];
#pragma unroll
                for (int bj = 0; bj < 2; ++bj)
#pragma unroll
                    for (int n = 0; n < 2; ++n) {
                        if (RES_BF16) { const u32x2 w = *(const u32x2*)(resid_b + off + bj * HALF + n * 16);
                            r[bj][n] = (f32x4){__uint_as_float(w.x << 16), __uint_as_float(w.x & 0xffff0000u), __uint_as_float(w.y << 16), __uint_as_float(w.y & 0xffff0000u)}; }
                        else r[bj][n] = *(const f32x4*)(resid_f + off + bj * HALF + n * 16);
                    }
#pragma unroll
                for (int bj = 0; bj < 2; ++bj)
#pragma unroll
                    for (int n = 0; n < 2; ++n) {
                        const f32x4 o = r[bj][n] + acc[ai][bj][m][n];
                        ss += (o[0] * o[0] + o[1] * o[1]) + (o[2] * o[2] + o[3] * o[3]);
                        u32x2 w; w.x = cvt_pk_bf16(o[0], o[1]); w.y = cvt_pk_bf16(o[2], o[3]); *(u32x2*)(xb + off + bj * HALF + n * 16) = w;
                    }
                ss += __shfl_xor(ss, 16); ss += __shfl_xor(ss, 32);
                if (fq == 0) ssp[(size_t)row * 16 + u.pn * 4 + wc] = ss;
                asm volatile("" ::: "memory");
            }
    }
};
struct EpiGlu {
    static constexpr bool PERM = true, AFTER_DRAIN = false;
    const bf16_t* Y; int ldy; const float* bias; bf16_t* O; int ldo; int ocol0;
    __device__ __forceinline__ void operator()(const f32x4 (&acc)[2][2][4][2], const Unit& u, int wr, int wc, int fr, int fq) const {
        const int row0 = u.pm * BM + wr * 64 + fr, col0 = u.pn * BM + wc * 32 + 8 * fq;
#pragma unroll
        for (int bj = 0; bj < 2; ++bj) {
            const f32x4 b0 = *(const f32x4*)(bias + col0 + bj * HALF), b1 = *(const f32x4*)(bias + col0 + bj * HALF + 4);
#pragma unroll
            for (int ai = 0; ai < 2; ++ai)
#pragma unroll
                for (int m = 0; m < 4; ++m) {
                    const int row = row0 + ai * HALF + m * 16;
                    const u32x4 yw = *(const u32x4*)(Y + (size_t)row * ldy + col0 + bj * HALF);
                    const f32x4 z0 = acc[ai][bj][m][0] + b0, z1 = acc[ai][bj][m][1] + b1;
                    float y[8], o[8];
                    y[0] = __uint_as_float(yw.x << 16); y[1] = __uint_as_float(yw.x & 0xffff0000u); y[2] = __uint_as_float(yw.y << 16); y[3] = __uint_as_float(yw.y & 0xffff0000u);
                    y[4] = __uint_as_float(yw.z << 16); y[5] = __uint_as_float(yw.z & 0xffff0000u); y[6] = __uint_as_float(yw.w << 16); y[7] = __uint_as_float(yw.w & 0xffff0000u);
#pragma unroll
                    for (int j = 0; j < 4; ++j) { o[j] = y[j] / (1.0f + __expf(-z0[j])); o[4 + j] = y[4 + j] / (1.0f + __expf(-z1[j])); }
                    u32x4 w; w.x = cvt_pk_bf16(o[0], o[1]); w.y = cvt_pk_bf16(o[2], o[3]); w.z = cvt_pk_bf16(o[4], o[5]); w.w = cvt_pk_bf16(o[6], o[7]);
                    *(u32x4*)(O + (size_t)row * ldo + ocol0 + col0 + bj * HALF) = w;
                }
        }
    }
};

template <class Epi, class Sched, bool ALIGN_EPI = false, bool SP2 = false>
__device__ __forceinline__ void gemm_phase(PG8_LAS unsigned char* lds, const Gemm g, const Sched& S, const Epi& E) {
    const int tid = threadIdx.x, wid = __builtin_amdgcn_readfirstlane(tid >> 6), lane = tid & 63, wr = wid >> 2, wc = wid & 3, fr = lane & 15, fq = lane >> 4;
    const int K = g.K, nt = K / BK;
    unsigned voffA[2], voffB[2];
#pragma unroll
    for (int i = 0; i < 2; ++i) { int R, C; stage_rc(tid * 16 + i * 8192, R, C); const int Rb = Epi::PERM ? ((R & ~31) + perm32(R & 31)) : R;
        voffA[i] = (unsigned)(R * K + C) * 2u; voffB[i] = (unsigned)(Rb * K + C) * 2u; }
    const size_t kstep = (size_t)(BK * 2);
    const size_t hstep = (size_t)HALF * K * 2;
    const size_t tstep = 2 * hstep;
    const unsigned ldsw = (unsigned)wid * 1024u;
    const int aoff = lds_byte(wr * 64 + fr, fq * 8), boff = lds_byte(wc * 32 + fr, fq * 8);
#define PG8_SA(b, h) (((b) * 2 + (h)) * HTB)
#define PG8_SB(b, h) ((4 + (b) * 2 + (h)) * HTB)
#define PG8_STAGE(bufoff, gbase, voff) do { _Pragma("unroll") for (int _i = 0; _i < 2; ++_i) \
        __builtin_amdgcn_global_load_lds((const unsigned*)((const char*)(gbase) + (voff)[_i]), (PG8_LAS unsigned*)(lds + (bufoff) + ldsw + _i * 8192), 16, 0, 0); } while (0)
#define PG8_LDA(dst, b, h) do { _Pragma("unroll") for (int m = 0; m < 4; ++m) _Pragma("unroll") for (int k = 0; k < 2; ++k) dst[m][k] = *(const PG8_LAS bf16x8*)(lds + PG8_SA(b, h) + aoff + m * 2048 + k * 1024); } while (0)
#define PG8_LDB(dst, b, h) do { _Pragma("unroll") for (int n = 0; n < 2; ++n) _Pragma("unroll") for (int k = 0; k < 2; ++k) dst[n][k] = *(const PG8_LAS bf16x8*)(lds + PG8_SB(b, h) + boff + n * 2048 + k * 1024); } while (0)
#define PG8_MMA(ai, bj, At, Bt) do { __builtin_amdgcn_s_setprio(1); _Pragma("unroll") for (int m = 0; m < 4; ++m) _Pragma("unroll") for (int n = 0; n < 2; ++n) _Pragma("unroll") for (int k = 0; k < 2; ++k) \
        acc[ai][bj][m][n] = __builtin_amdgcn_mfma_f32_16x16x32_bf16(Bt[n][k], At[m][k], acc[ai][bj][m][n], 0, 0, 0); __builtin_amdgcn_s_setprio(0); } while (0)
#define PG8_WAIT_V(n) asm volatile("s_waitcnt vmcnt(" #n ")" ::: "memory")
#define PG8_WAIT_L(n) asm volatile("s_waitcnt lgkmcnt(" #n ")" ::: "memory")
#define PG8_BAR __builtin_amdgcn_s_barrier()
#define PG8_SCHED __builtin_amdgcn_sched_barrier(0)
    Unit cur, nxt; int ui = 0;
    if (!S.next(0, cur)) return;
    f32x4 acc[2][2][4][2];
#pragma unroll
    for (int a = 0; a < 2; ++a)
#pragma unroll
        for (int b = 0; b < 2; ++b)
#pragma unroll
            for (int m = 0; m < 4; ++m)
#pragma unroll
                for (int n = 0; n < 2; ++n) acc[a][b][m][n] = (f32x4){0.f, 0.f, 0.f, 0.f};
    bf16x8 At[4][2], B0[2][2], B1[2][2];
    const char* cA = (const char*)g.A + (size_t)cur.pm * tstep; const char* cB = (const char*)g.Bt + (size_t)cur.pn * tstep;
    S.a_ready(cur);
    if constexpr (SP2) {
        PG8_STAGE(PG8_SB(0, 0), cB, voffB); PG8_STAGE(PG8_SB(0, 1), cB + hstep, voffB); PG8_STAGE(PG8_SA(0, 0), cA, voffA); PG8_STAGE(PG8_SA(0, 1), cA + hstep, voffA);
        if (wr == 1) PG8_BAR;
        PG8_WAIT_V(2); PG8_BAR;
        PG8_STAGE(PG8_SB(1, 0), cB + kstep, voffB); PG8_STAGE(PG8_SA(1, 0), cA + kstep, voffA); PG8_STAGE(PG8_SB(1, 1), cB + hstep + kstep, voffB);
        PG8_WAIT_V(6); PG8_BAR;
    } else {
        PG8_STAGE(PG8_SB(0, 0), cB, voffB); PG8_STAGE(PG8_SA(0, 0), cA, voffA); PG8_STAGE(PG8_SB(0, 1), cB + hstep, voffB); PG8_STAGE(PG8_SA(0, 1), cA + hstep, voffA);
        if (wr == 1) PG8_BAR;
        PG8_WAIT_V(4); PG8_BAR;
        PG8_STAGE(PG8_SB(1, 0), cB + kstep, voffB); PG8_STAGE(PG8_SA(1, 0), cA + kstep, voffA); PG8_STAGE(PG8_SB(1, 1), cB + hstep + kstep, voffB);
        PG8_WAIT_V(6); PG8_BAR;
    }
    for (;;) {
        const bool has_next = S.next(ui + 1, nxt);
        const char* nA = has_next ? (const char*)g.A + (size_t)nxt.pm * tstep : cA; const char* nB = has_next ? (const char*)g.Bt + (size_t)nxt.pn * tstep : cB;
        for (int t = 0; t < nt; t += 2) {
            const bool last = (t == nt - 2);
            const char* a1 = cA + (size_t)(t + 1) * kstep;
            const char* a2 = last ? nA : cA + (size_t)(t + 2) * kstep; const char* b2 = last ? nB : cB + (size_t)(t + 2) * kstep;
            const char* a3 = a2 + kstep; const char* b3 = b2 + kstep;
            if (last && has_next) S.a_ready(nxt);
            if constexpr (SP2) {
            PG8_LDB(B0, 0, 0); PG8_LDB(B1, 0, 1); PG8_SCHED; PG8_LDA(At, 0, 0); PG8_STAGE(PG8_SA(1, 1), a1 + hstep, voffA);
            PG8_WAIT_V(8); PG8_WAIT_L(0); PG8_BAR; PG8_MMA(0, 0, At, B0); PG8_MMA(0, 1, At, B1); PG8_BAR; PG8_SCHED;
            PG8_LDA(At, 0, 1); PG8_STAGE(PG8_SB(0, 0), b2, voffB); PG8_STAGE(PG8_SB(0, 1), b2 + hstep, voffB); PG8_STAGE(PG8_SA(0, 0), a2, voffA);
            PG8_WAIT_V(8); PG8_WAIT_L(0); PG8_BAR; PG8_MMA(1, 0, At, B0); PG8_MMA(1, 1, At, B1); PG8_BAR; PG8_SCHED;
            PG8_LDB(B0, 1, 0); PG8_LDB(B1, 1, 1); PG8_SCHED; PG8_LDA(At, 1, 0); PG8_STAGE(PG8_SA(0, 1), a2 + hstep, voffA);
            PG8_WAIT_V(8); PG8_WAIT_L(0); PG8_BAR; PG8_MMA(0, 0, At, B0); PG8_MMA(0, 1, At, B1); PG8_BAR; PG8_SCHED;
            PG8_LDA(At, 1, 1); PG8_STAGE(PG8_SB(1, 0), b3, voffB); PG8_STAGE(PG8_SB(1, 1), b3 + hstep, voffB); PG8_STAGE(PG8_SA(1, 0), a3, voffA);
            PG8_WAIT_V(8); PG8_WAIT_L(0); PG8_BAR; PG8_MMA(1, 0, At, B0); PG8_MMA(1, 1, At, B1); PG8_BAR; PG8_SCHED;
            } else {
            PG8_LDB(B0, 0, 0); PG8_SCHED; PG8_LDA(At, 0, 0); PG8_STAGE(PG8_SA(1, 1), a1 + hstep, voffA);
            PG8_WAIT_L(8); PG8_BAR; PG8_WAIT_L(0); PG8_MMA(0, 0, At, B0); PG8_BAR; PG8_SCHED;
            PG8_LDB(B1, 0, 1); PG8_STAGE(PG8_SB(0, 0), b2, voffB);
            PG8_BAR; PG8_WAIT_L(0); PG8_MMA(0, 1, At, B1); PG8_BAR;
            PG8_LDA(At, 0, 1); PG8_STAGE(PG8_SA(0, 0), a2, voffA);
            PG8_BAR; PG8_WAIT_L(0); PG8_MMA(1, 0, At, B0); PG8_BAR; PG8_SCHED;
            PG8_STAGE(PG8_SB(0, 1), b2 + hstep, voffB);
            PG8_WAIT_V(6); PG8_BAR; PG8_MMA(1, 1, At, B1); PG8_BAR;
            PG8_LDB(B0, 1, 0); PG8_SCHED; PG8_LDA(At, 1, 0); PG8_STAGE(PG8_SA(0, 1), a2 + hstep, voffA);
            PG8_WAIT_L(8); PG8_BAR; PG8_WAIT_L(0); PG8_MMA(0, 0, At, B0); PG8_BAR; PG8_SCHED;
            PG8_LDB(B1, 1, 1); PG8_STAGE(PG8_SB(1, 0), b3, voffB);
            PG8_BAR; PG8_WAIT_L(0); PG8_MMA(0, 1, At, B1); PG8_BAR;
            PG8_LDA(At, 1, 1); PG8_STAGE(PG8_SA(1, 0), a3, voffA);
            PG8_BAR; PG8_WAIT_L(0); PG8_MMA(1, 0, At, B0); PG8_BAR; PG8_SCHED;
            PG8_STAGE(PG8_SB(1, 1), b3 + hstep, voffB);
            PG8_WAIT_V(6); PG8_BAR; PG8_MMA(1, 1, At, B1); PG8_BAR;
            }
        }
        if constexpr (ALIGN_EPI) { if (wr == 0) PG8_BAR; }
        if constexpr (!Epi::AFTER_DRAIN) { E(acc, cur, wr, wc, fr, fq); S.done(cur); }
        if (!has_next) break;
#pragma unroll
        for (int a = 0; a < 2; ++a)
#pragma unroll
            for (int b = 0; b < 2; ++b)
#pragma unroll
                for (int m = 0; m < 4; ++m)
#pragma unroll
                    for (int n = 0; n < 2; ++n) acc[a][b][m][n] = (f32x4){0.f, 0.f, 0.f, 0.f};
        cur = nxt; cA = nA; cB = nB; ++ui;
        if constexpr (ALIGN_EPI) { if (wr == 1) PG8_BAR; }
    }
    PG8_WAIT_V(0);
    if constexpr (!ALIGN_EPI) { if (wr == 0) PG8_BAR; }
    PG8_BAR;
    if constexpr (Epi::AFTER_DRAIN) { E.fused(acc, cur, wr, wc, fr, fq, lds, wid, lane); S.done(cur); }
#undef PG8_SA
#undef PG8_SB
#undef PG8_STAGE
#undef PG8_LDA
#undef PG8_LDB
#undef PG8_MMA
#undef PG8_WAIT_V
#undef PG8_WAIT_L
#undef PG8_BAR
#undef PG8_SCHED
}
}
namespace attn_body {
using bf16=__hip_bfloat16;
using bf16x8=__attribute__((ext_vector_type(8)))short;
using s16x4=__attribute__((ext_vector_type(4)))short;
using f32x16=__attribute__((ext_vector_type(16)))float;
using u32x4=__attribute__((ext_vector_type(4)))unsigned;
constexpr int BATCH=8,NHEAD=8,SEQ=4096,D=64,DM=NHEAD*D,DMO=1024;
constexpr int NW=8,QBLK=32,QB=QBLK*NW,KVBLK=64,NQB=SEQ/QB;
constexpr int ATTN_PITCH=DM, ATTN_UNIT_ROWS=QB;
constexpr int LDS_CK_OFF=83968;
__device__ __forceinline__ int crow(int r,int hi){return (r&3)+8*(r>>2)+4*hi;}
#define SBAR() __builtin_amdgcn_sched_barrier(0)
__device__ __forceinline__ void cmask(f32x16&p0,f32x16&p1,int jb,int qrel,int hi){
  const float NEG=-INFINITY; int kb=64*jb+4*hi;
  #pragma unroll
  for(int r=0;r<16;++r){int kv=kb+(r&3)+8*(r>>2); if(kv>qrel)p0[r]=NEG; if(kv+32>qrel)p1[r]=NEG;}
}

constexpr int NSLOT=3, SLOTB=8192;
constexpr int LDS_K=0, LDS_V=NSLOT*SLOTB, LDS_WS=2*NSLOT*SLOTB, LDS_OST=LDS_WS+NW*64*4, LDS_BYTES=LDS_OST+NW*4096;
constexpr float C2=0.125f*1.4426950408889634f;
__device__ __forceinline__ void glds16(const void*gsrc,unsigned lds_dst){unsigned keep;
  asm volatile("s_mov_b32 %0, m0\n\ts_mov_b32 m0, %2\n\ts_nop 0\n\tglobal_load_lds_dwordx4 %1, off\n\ts_mov_b32 m0, %0":"=&s"(keep):"v"(gsrc),"s"(lds_dst):"memory");}
__device__ __forceinline__ float max3f(float a,float b,float c){float r;asm("v_max3_f32 %0, %1, %2, %3":"=v"(r):"v"(a),"v"(b),"v"(c));return r;}
__device__ __forceinline__ float max2f(float a,float b){float r;asm("v_max_f32_e32 %0, %1, %2":"=v"(r):"v"(a),"v"(b));return r;}
__device__ __forceinline__ float fadd_s(float a,float b){float r;asm("v_add_f32_e32 %0, %1, %2":"=v"(r):"v"(a),"v"(b));return r;}
__device__ __forceinline__ float fsub_s(float a,float b){float r;asm("v_sub_f32_e32 %0, %1, %2":"=v"(r):"v"(a),"v"(b));return r;}
typedef float f32x2_t __attribute__((ext_vector_type(2))); typedef __bf16 bf16x2_t __attribute__((ext_vector_type(2)));
__device__ __forceinline__ unsigned cvtpk_s(float lo,float hi){f32x2_t v={lo,hi};bf16x2_t b=__builtin_convertvector(v,bf16x2_t);return __builtin_bit_cast(unsigned,b);}
#define WAIT_BAR(N) asm volatile("s_waitcnt vmcnt(" #N ") lgkmcnt(0)\n\ts_barrier":::"memory")

__device__ __forceinline__ void qkt(f32x16&p0,f32x16&p1,const char*Kslot,const bf16x8*qr,const f32x16&ini0,const f32x16&ini1,int r32,int hi){
  const char*kb=Kslot+hi*1024+r32*16;
  #pragma unroll
  for(int d0=0;d0<4;++d0){
    const bf16x8 b0=*reinterpret_cast<const bf16x8*>(kb+d0*2048);
    const bf16x8 b1=*reinterpret_cast<const bf16x8*>(kb+d0*2048+512);
    if(d0==0){p0=__builtin_amdgcn_mfma_f32_32x32x16_bf16(b0,qr[0],ini0,0,0,0);p1=__builtin_amdgcn_mfma_f32_32x32x16_bf16(b1,qr[0],ini1,0,0,0);}
    else{p0=__builtin_amdgcn_mfma_f32_32x32x16_bf16(b0,qr[d0],p0,0,0,0);p1=__builtin_amdgcn_mfma_f32_32x32x16_bf16(b1,qr[d0],p1,0,0,0);}}
}
typedef __attribute__((address_space(3))) const char* lds_cptr;
typedef short v4i16_t __attribute__((ext_vector_type(4)));
__device__ __forceinline__ void kload8(bf16x8*kf,lds_cptr kp){
  kf[0]=*(const __attribute__((address_space(3))) bf16x8*)(kp);      kf[1]=*(const __attribute__((address_space(3))) bf16x8*)(kp+512);
  kf[2]=*(const __attribute__((address_space(3))) bf16x8*)(kp+2048); kf[3]=*(const __attribute__((address_space(3))) bf16x8*)(kp+2560);
  kf[4]=*(const __attribute__((address_space(3))) bf16x8*)(kp+4096); kf[5]=*(const __attribute__((address_space(3))) bf16x8*)(kp+4608);
  kf[6]=*(const __attribute__((address_space(3))) bf16x8*)(kp+6144); kf[7]=*(const __attribute__((address_space(3))) bf16x8*)(kp+6656);
}
__device__ __forceinline__ void kload2(bf16x8*kf,lds_cptr kp,int j){ kf[2*j]=*(const __attribute__((address_space(3))) bf16x8*)(kp+j*2048); kf[2*j+1]=*(const __attribute__((address_space(3))) bf16x8*)(kp+j*2048+512); }
__device__ __forceinline__ s16x4 vtr(lds_cptr p){ return __builtin_bit_cast(s16x4,__builtin_amdgcn_ds_read_tr16_b64_v4i16((__attribute__((address_space(3))) v4i16_t*)p)); }
__device__ __forceinline__ float rowmax(const f32x16&p0,const f32x16&p1){
  float a=max3f(p0[0],p0[1],p1[0]),b=max3f(p0[2],p0[3],p1[1]);a=max3f(a,p1[2],p1[3]);
  #pragma unroll
  for(int r=4;r<16;r+=4){a=max3f(a,p0[r],p0[r+1]);b=max3f(b,p0[r+2],p0[r+3]);a=max3f(a,p1[r],p1[r+1]);b=max3f(b,p1[r+2],p1[r+3]);}
  const float m=max2f(a,b);
  auto rr=__builtin_amdgcn_permlane32_swap(__float_as_uint(m),__float_as_uint(m),false,false);
  return max2f(__uint_as_float(rr[0]),__uint_as_float(rr[1]));
}
__device__ __forceinline__ void pv(f32x16*o,int vb,bf16x8 pa0,bf16x8 pa1,bf16x8 pa2,bf16x8 pa3){
  #pragma unroll
  for(int d0=0;d0<2;++d0){s16x4 lo[4],hi[4];
    #pragma unroll
    for(int ks=0;ks<4;++ks){
      asm volatile("ds_read_b64_tr_b16 %0,%1 offset:%c2":"=&v"(lo[ks]):"v"(vb),"i"(d0*4096+ks*1024):"memory");
      asm volatile("ds_read_b64_tr_b16 %0,%1 offset:%c2":"=&v"(hi[ks]):"v"(vb),"i"(d0*4096+ks*1024+512):"memory");}
    asm volatile("s_waitcnt lgkmcnt(0)":::"memory");SBAR();
    #define PK(k) (bf16x8){lo[k][0],lo[k][1],lo[k][2],lo[k][3],hi[k][0],hi[k][1],hi[k][2],hi[k][3]}
    o[d0]=__builtin_amdgcn_mfma_f32_32x32x16_bf16(pa0,PK(0),o[d0],0,0,0);
    o[d0]=__builtin_amdgcn_mfma_f32_32x32x16_bf16(pa1,PK(1),o[d0],0,0,0);
    o[d0]=__builtin_amdgcn_mfma_f32_32x32x16_bf16(pa2,PK(2),o[d0],0,0,0);
    o[d0]=__builtin_amdgcn_mfma_f32_32x32x16_bf16(pa3,PK(3),o[d0],0,0,0);
    #undef PK
  }
}

#ifndef ATTN_STORE16
#define ATTN_STORE16(p,v) (*(u32x4*)(p)=(v))
#endif
template<int THRL> __device__ __forceinline__ void attn_unit(int b,int h,int qb,const bf16*Q,const bf16*__restrict__ K,const bf16*__restrict__ V,bf16*O,const float*CB,char*shm){
  const int tid=threadIdx.x,lane=tid&63,r32=lane&31,hi=lane>>5; const int wid=__builtin_amdgcn_readfirstlane(tid>>6);
  const long rowbase=(long)b*SEQ; const int q0=qb*QB;
  typedef float f32x4_t __attribute__((ext_vector_type(4)));
  const float*cbh=CB+(long)(b*NHEAD+h)*SEQ;
  { const int n4=(q0+QB)/4; __attribute__((address_space(3))) f32x4_t*ckl=(__attribute__((address_space(3))) f32x4_t*)((lds_cptr)shm+LDS_CK_OFF);
    for(int i=tid;i<n4;i+=NW*64)ckl[i]=((const f32x4_t*)cbh)[i]; }
  const bf16*Qw=Q+(rowbase+q0+wid*QBLK)*DM+h*D;
  const bf16*Kh=K+rowbase*DM+h*D,*Vh=V+rowbase*DM+h*D;
  const unsigned lds0=(unsigned)(uintptr_t)shm;
  float*wsf=(float*)(shm+LDS_WS)+wid*64;
  const bf16*ksrc=Kh+(long)lane*DM+wid*8;
  const bf16*vsrc=Vh+(long)(16*(wid&3)+(lane>>2))*DM+(wid>>2)*32+(lane&3)*8;
  const unsigned kdst=lds0+LDS_K+wid*1024, vdst=lds0+LDS_V+wid*1024;
  #define DMA_K(t,slot) glds16(ksrc+(long)(t)*KVBLK*DM,(unsigned)__builtin_amdgcn_readfirstlane(kdst+(slot)))
  #define DMA_V(t,slot) glds16(vsrc+(long)(t)*KVBLK*DM,(unsigned)__builtin_amdgcn_readfirstlane(vdst+(slot)))
  const int vb0=(int)(lds0+LDS_V)+((lane>>4)&1)*32+(lane&3)*8+(4*hi+((lane&15)>>2))*64;
  const char*Kbase=shm+LDS_K; bf16x8 kf[8];
  const lds_cptr shm3=(lds_cptr)shm; const lds_cptr kp0=shm3+LDS_K+hi*1024+r32*16; const lds_cptr vp0=shm3+LDS_V+((lane>>4)&1)*32+(lane&3)*8+(4*hi+((lane&15)>>2))*64;
  const int NT=(q0+QB)/KVBLK;
  DMA_K(0,0);DMA_V(0,0);DMA_K(1,SLOTB);
  bf16x8 qr[4];
  #pragma unroll
  for(int d0=0;d0<4;++d0)qr[d0]=*reinterpret_cast<const bf16x8*>(&Qw[(long)r32*DM+d0*16+hi*8]);
  float mhat,l_reg=0.f;f32x16 o[2];o[0]=f32x16{};o[1]=f32x16{};
  const float cq=cbh[q0+wid*QBLK+r32];
  {
    const bf16*Kw=Kh+(long)(q0+wid*QBLK+r32)*DM; float sd=0.f;
    _Pragma("unroll") for(int d0=0;d0<4;++d0){ const bf16x8 kk=*reinterpret_cast<const bf16x8*>(&Kw[d0*16+hi*8]);
      _Pragma("unroll") for(int j=0;j<8;++j) sd+=__uint_as_float((unsigned)(unsigned short)qr[d0][j]<<16)*__uint_as_float((unsigned)(unsigned short)kk[j]<<16); }
    auto rs_=__builtin_amdgcn_permlane32_swap(__float_as_uint(sd),__float_as_uint(sd),false,false); mhat=__uint_as_float(rs_[0])+__uint_as_float(rs_[1]); }
  float cqm=cq-mhat;
  const __attribute__((address_space(3))) float*ckb=(const __attribute__((address_space(3))) float*)((lds_cptr)shm+LDS_CK_OFF)+4*hi;
  #define CINIT(C0,C1,t) do{ const __attribute__((address_space(3))) float*cp_=ckb+64*(t); \
    _Pragma("unroll") for(int g_=0;g_<4;++g_){ const f32x4_t a_=*(const __attribute__((address_space(3))) f32x4_t*)(cp_+8*g_), b_=*(const __attribute__((address_space(3))) f32x4_t*)(cp_+32+8*g_); \
      _Pragma("unroll") for(int j_=0;j_<4;++j_){ C0[4*g_+j_]=cqm-a_[j_]; C1[4*g_+j_]=cqm-b_[j_]; } } }while(0)
  const int qrel=wid*QBLK+r32;
  #define CMASK(P0,P1,t) do{int jb_=(t)-(NT-4); if(jb_>=0)cmask(P0,P1,jb_,qrel,hi);}while(0)
  bool resc=false;
  #define START(P0,P1) do{ const float rm=rowmax(P0,P1); resc=false; \
    { const float dl=max2f(rm,0.f); mhat=fadd_s(mhat,dl); \
      _Pragma("unroll") for(int r=0;r<16;++r){P0[r]=fsub_s(P0[r],dl);P1[r]=fsub_s(P1[r],dl);} \
      cqm=cq-mhat; } \
    _Pragma("unroll") for(int r=0;r<16;++r)P0[r]=__builtin_amdgcn_exp2f(P0[r]); }while(0)
  #define RESC() do{ if(resc){ asm volatile("s_waitcnt lgkmcnt(0)":::"memory"); \
      _Pragma("unroll") for(int d_=0;d_<2;++d_) _Pragma("unroll") for(int r=0;r<16;++r)o[d_][r]*=wsf[crow(r,hi)]; } }while(0)
  f32x16 pA0,pA1,pB0,pB1;
  int sl_prev=0,sl_cur=0,sl_next=SLOTB;
  #define ROT() do{sl_prev=sl_cur;sl_cur=sl_next;sl_next=(sl_next==(NSLOT-1)*SLOTB)?0:sl_next+SLOTB;}while(0)
  DMA_K(2,2*SLOTB);
  WAIT_BAR(3);
  { f32x16 i0_,i1_; CINIT(i0_,i1_,0); qkt(pA0,pA1,Kbase,qr,i0_,i1_,r32,hi); } asm volatile("s_nop 15\n\ts_nop 7":"+v"(pA0),"+v"(pA1));CMASK(pA0,pA1,0);
  START(pA0,pA1);
  _Pragma("unroll") for(int r=0;r<16;++r)pA1[r]=__builtin_amdgcn_exp2f(pA1[r]);
  WAIT_BAR(0);
  DMA_K(3,0);DMA_V(1,SLOTB);
  ROT();
  kload8(kf,kp0+sl_cur);
  WAIT_BAR(2);
  s16x4 vlo[8],vhi[8]; u32x4 pw0,pw1,pw2,pw3;
  #define PKW(P,B) cvtpk_s(P[B],P[B+1])
  #define PAF(k) __builtin_bit_cast(bf16x8,pw##k)
  #define VFR(i) (bf16x8){vlo[i][0],vlo[i][1],vlo[i][2],vlo[i][3],vhi[i][0],vhi[i][1],vhi[i][2],vhi[i][3]}
  #define PIN(x) asm volatile("":"+v"(x))
  #define MX3(a,b,c) __builtin_fmaxf(__builtin_fmaxf((a),(b)),(c))
  #define GAPA(MF,A0,A1,A2,A3,W0,W1,PW) do{ MF; sacc+=A0; sacc+=A1; sacc+=A2; sacc+=A3; PIN(sacc); W0; W1; PIN(PW); SBAR(); }while(0)
  #define EX(v) __builtin_amdgcn_exp2f(v)
  #define GAPB(MF,X,B) do{ MF; X[B]=EX(X[B]); X[B+1]=EX(X[B+1]); X[B+2]=EX(X[B+2]); X[B+3]=EX(X[B+3]); PIN(X); SBAR(); }while(0)
  #define VRD(i) do{ vlo[i]=vtr(vp_+(((i)>>2)*4096+((i)&3)*1024)); vhi[i]=vtr(vp_+(((i)>>2)*4096+((i)&3)*1024+512)); }while(0)
  #define KRD(G,j) do{ if(G){ kload2(kf,kp0+sl_next,j); SBAR(); } }while(0)
  #define STEP(C0,C1,P0,P1,t,GK,GV,GL) do{ SBAR(); CINIT(C0,C1,t); SBAR(); \
    const lds_cptr vp_=vp0+sl_prev; \
    VRD(0); SBAR(); float sacc=(P0[0]+P0[1]); \
    GAPA(C0=__builtin_amdgcn_mfma_f32_32x32x16_bf16(kf[0],qr[0],C0,0,0,0), P0[2],P0[3],P0[4],P0[5],     pw0[0]=PKW(P0,0), pw0[1]=PKW(P0,2), pw0); \
    VRD(4); SBAR(); GAPA(C1=__builtin_amdgcn_mfma_f32_32x32x16_bf16(kf[1],qr[0],C1,0,0,0), P0[6],P0[7],P0[8],P0[9],     pw0[2]=PKW(P0,4), pw0[3]=PKW(P0,6), pw0); \
    VRD(1); SBAR(); GAPA(C0=__builtin_amdgcn_mfma_f32_32x32x16_bf16(kf[2],qr[1],C0,0,0,0),   P0[10],P0[11],P0[12],P0[13], pw1[0]=PKW(P0,8), pw1[1]=PKW(P0,10), pw1); \
    VRD(5); SBAR(); GAPA(C1=__builtin_amdgcn_mfma_f32_32x32x16_bf16(kf[3],qr[1],C1,0,0,0),   P0[14],P0[15],P1[0],P1[1],   pw1[2]=PKW(P0,12),pw1[3]=PKW(P0,14), pw1); \
    VRD(2); SBAR(); GAPA(C0=__builtin_amdgcn_mfma_f32_32x32x16_bf16(kf[4],qr[2],C0,0,0,0),   P1[2],P1[3],P1[4],P1[5],     pw2[0]=PKW(P1,0), pw2[1]=PKW(P1,2), pw2); \
    VRD(6); SBAR(); GAPA(C1=__builtin_amdgcn_mfma_f32_32x32x16_bf16(kf[5],qr[2],C1,0,0,0),   P1[6],P1[7],P1[8],P1[9],     pw2[2]=PKW(P1,4), pw2[3]=PKW(P1,6), pw2); \
    VRD(3); SBAR(); GAPA(C0=__builtin_amdgcn_mfma_f32_32x32x16_bf16(kf[6],qr[3],C0,0,0,0),   P1[10],P1[11],P1[12],P1[13], pw3[0]=PKW(P1,8), pw3[1]=PKW(P1,10), pw3); \
    VRD(7); SBAR(); GAPA(C1=__builtin_amdgcn_mfma_f32_32x32x16_bf16(kf[7],qr[3],C1,0,0,0),   P1[14],P1[15],0.f,0.f,       pw3[2]=PKW(P1,12),pw3[3]=PKW(P1,14), pw3); \
    l_reg+=sacc; \
    if(GK){DMA_K((t)+3,sl_cur);} if(GV){DMA_V((t)+1,sl_next);} \
    CMASK(C0,C1,t); \
    { float a=MX3(C0[0],C0[1],C1[0]),b=MX3(C0[2],C0[3],C1[1]); a=MX3(a,C1[2],C1[3]); \
      _Pragma("unroll") for(int r=4;r<16;r+=4){a=MX3(a,C0[r],C0[r+1]);b=MX3(b,C0[r+2],C0[r+3]);a=MX3(a,C1[r],C1[r+1]);b=MX3(b,C1[r+2],C1[r+3]);} \
      float rm=__builtin_fmaxf(a,b); { auto rr=__builtin_amdgcn_permlane32_swap(__float_as_uint(rm),__float_as_uint(rm),false,false); rm=__builtin_fmaxf(__uint_as_float(rr[0]),__uint_as_float(rr[1])); } \
      resc=false; \
      if(__builtin_expect(__any(rm>(float)THRL),0)){ const float dl=__builtin_fmaxf(rm,0.f); mhat+=dl; \
        _Pragma("unroll") for(int r=0;r<16;++r){C0[r]-=dl;C1[r]-=dl;} \
        cqm=cq-mhat; \
        const float f=__builtin_amdgcn_exp2f(-dl); l_reg*=f; if(hi==0)wsf[r32]=f; resc=true; } } \
    SBAR(); \
    GAPB(o[0]=__builtin_amdgcn_mfma_f32_32x32x16_bf16(PAF(0),VFR(0),o[0],0,0,0), C0,0); \
    GAPB(o[1]=__builtin_amdgcn_mfma_f32_32x32x16_bf16(PAF(0),VFR(4),o[1],0,0,0), C0,4); \
    KRD(GL,0); GAPB(o[0]=__builtin_amdgcn_mfma_f32_32x32x16_bf16(PAF(1),VFR(1),o[0],0,0,0), C0,8); \
    KRD(GL,1); GAPB(o[1]=__builtin_amdgcn_mfma_f32_32x32x16_bf16(PAF(1),VFR(5),o[1],0,0,0), C0,12); \
    KRD(GL,2); GAPB(o[0]=__builtin_amdgcn_mfma_f32_32x32x16_bf16(PAF(2),VFR(2),o[0],0,0,0), C1,0); \
    KRD(GL,3); GAPB(o[1]=__builtin_amdgcn_mfma_f32_32x32x16_bf16(PAF(2),VFR(6),o[1],0,0,0), C1,4); \
    GAPB(o[0]=__builtin_amdgcn_mfma_f32_32x32x16_bf16(PAF(3),VFR(3),o[0],0,0,0), C1,8); \
    GAPB(o[1]=__builtin_amdgcn_mfma_f32_32x32x16_bf16(PAF(3),VFR(7),o[1],0,0,0), C1,12); \
    }while(0)
  int t=1;
  #undef CMASK
  #define CMASK(P0,P1,t) do{}while(0)
  for(;t+5<NT;t+=2){
    STEP(pB0,pB1,pA0,pA1,t,true,true,true);     WAIT_BAR(2); RESC(); ROT();
    STEP(pA0,pA1,pB0,pB1,t+1,true,true,true);   WAIT_BAR(2); RESC(); ROT();
  }
  #undef CMASK
  #define CMASK(P0,P1,t) do{int jb_=(t)-(NT-4); if(jb_>=0)cmask(P0,P1,jb_,qrel,hi);}while(0)
  #define ENDW(tt) do{ if((tt)+3<NT){WAIT_BAR(2);} else if((tt)+2<NT){WAIT_BAR(1);} else {WAIT_BAR(0);} }while(0)
  for(;t+1<NT;t+=2){
    STEP(pB0,pB1,pA0,pA1,t,(t+3<NT),(t+1<NT),(t+1<NT));       ENDW(t);   RESC(); ROT();
    STEP(pA0,pA1,pB0,pB1,t+1,(t+4<NT),(t+2<NT),(t+2<NT));     ENDW(t+1); RESC(); ROT();
  }
  STEP(pB0,pB1,pA0,pA1,NT-1,false,false,false); RESC();
  { float sacc=pB0[0]+pB0[1]; _Pragma("unroll") for(int r=2;r<16;++r)sacc+=pB0[r]; _Pragma("unroll") for(int r=0;r<16;++r)sacc+=pB1[r]; l_reg+=sacc;
    pw0=(u32x4){PKW(pB0,0),PKW(pB0,2),PKW(pB0,4),PKW(pB0,6)};pw1=(u32x4){PKW(pB0,8),PKW(pB0,10),PKW(pB0,12),PKW(pB0,14)};pw2=(u32x4){PKW(pB1,0),PKW(pB1,2),PKW(pB1,4),PKW(pB1,6)};pw3=(u32x4){PKW(pB1,8),PKW(pB1,10),PKW(pB1,12),PKW(pB1,14)};
    SBAR(); pv(o,vb0+sl_cur,PAF(0),PAF(1),PAF(2),PAF(3)); }
  #undef PKW
  #undef PAF
  #undef VFR
  #undef PIN
  #undef MX3
  #undef GAPA
  #undef GAPB
  #undef EX
  #undef VRD
  #undef KRD
  #undef STEP
  #undef ENDW
  {auto rr=__builtin_amdgcn_permlane32_swap(__float_as_uint(l_reg),__float_as_uint(l_reg),false,false);l_reg=__uint_as_float(rr[0])+__uint_as_float(rr[1]);}
  if(hi==0)wsf[32+r32]=l_reg;asm volatile("s_waitcnt lgkmcnt(0)":::"memory");
  float rli[16];
  #pragma unroll
  for(int r=0;r<16;++r)rli[r]=__builtin_amdgcn_rcpf(wsf[32+crow(r,hi)]);
  bf16*Ow=O+(rowbase+q0+wid*QBLK)*DMO+h*D;
  { bf16*stg=(bf16*)(shm+LDS_OST)+wid*2048;
    #pragma unroll
    for(int r=0;r<16;++r){const int orow=crow(r,hi);
      #pragma unroll
      for(int d0=0;d0<2;++d0)stg[orow*64+d0*32+r32]=__float2bfloat16(o[d0][r]*rli[r]);}
    asm volatile("s_waitcnt lgkmcnt(0)":::"memory");
    #pragma unroll
    for(int i=0;i<4;++i){const int row=i*8+(lane>>3),ch=lane&7; const u32x4 v=*(const u32x4*)(stg+row*64+ch*8); ATTN_STORE16(Ow+(long)row*DMO+ch*8,v);} }
  asm volatile("s_waitcnt lgkmcnt(0)\n\ts_barrier":::"memory");
  #undef CINIT
  #undef DMA_K
  #undef DMA_V
  #undef CMASK
  #undef START
  #undef RESC
  #undef ROT
}
constexpr int ATTN_LDS_BYTES=LDS_BYTES;
struct AttnTensors { const bf16* Q; const bf16* K; const bf16* V; bf16* O; const float* CB; };
struct AttnUnit { int bh; int qb; };
struct StaticOrder {
  int vcu;
  __device__ __forceinline__ explicit StaticOrder(int grid,int block):vcu((block%8)*(grid/8)+block/8){}
  __device__ __forceinline__ bool next(int i,AttnUnit&u)const{ if(i>=4||vcu>=64*4)return false; const int s=vcu&3; u.bh=vcu>>2; u.qb=(i==0)?s:(i==1)?7-s:(i==2)?8+s:15-s; return true; }
  __device__ __forceinline__ void a_ready(const AttnUnit&)const{}
  __device__ __forceinline__ void done(const AttnUnit&)const{}
};
template<class Sched,int THRL=8> __device__ __forceinline__ void attn_phase(char*lds,const AttnTensors&T,const Sched&S){
  AttnUnit u;
  for(int i=0;S.next(i,u);++i){ S.a_ready(u); attn_unit<THRL>(u.bh/NHEAD,u.bh%NHEAD,u.qb,T.Q,T.K,T.V,T.O,T.CB,lds); S.done(u); }
}
#undef SBAR
#undef WAIT_BAR
}
#define GAS __attribute__((address_space(1)))
#define LAS __attribute__((address_space(3)))
typedef unsigned short bf16;
typedef unsigned v4u __attribute__((ext_vector_type(4)));
typedef float f32x4 __attribute__((ext_vector_type(4)));
typedef short bf16x8 __attribute__((ext_vector_type(8)));
typedef GAS unsigned gu32;
typedef GAS unsigned long long gu64;
#define RLX_AGENT __ATOMIC_RELAXED, __HIP_MEMORY_SCOPE_AGENT
#define LDS_WAIT() asm volatile("s_waitcnt lgkmcnt(0)" ::: "memory")
#define VM_WAIT() asm volatile("s_waitcnt vmcnt(0)" ::: "memory")
__device__ __forceinline__ unsigned long long rt() { return __builtin_amdgcn_s_memrealtime(); }
__device__ __forceinline__ unsigned f2bf(float f) { unsigned u = __builtin_bit_cast(unsigned, f); return (u + 0x7fffu + ((u >> 16) & 1u)) >> 16; }
__device__ __forceinline__ unsigned pk2(float lo, float hi) { return f2bf(lo) | (f2bf(hi) << 16); }

#define XB_TMO      128
#define XB_XCNT(j)  (256  + 64 * (j))
#define XB_XSUB(j)  (1280 + 64 * (j))
#define XB_XGEN(j)  (2304 + 64 * (j))
#define XB_TOP      3328
#define XB_TOPGEN   3392
#define XCD_BAR_WORDS 3456
#define XB_SPIN_CAP (1u << 18)

__device__ __forceinline__ unsigned xb_ld(unsigned* p)              { return __hip_atomic_load(p, __ATOMIC_RELAXED, __HIP_MEMORY_SCOPE_AGENT); }
__device__ __forceinline__ unsigned xb_add(unsigned* p, unsigned v) { return __hip_atomic_fetch_add(p, v, __ATOMIC_RELAXED, __HIP_MEMORY_SCOPE_AGENT); }
__device__ __forceinline__ unsigned xb_xcc_id() { return (unsigned)__builtin_amdgcn_s_getreg((3 << 11) | 20) & 0xFu; }
#define XB_SPIN(cond, bar) do { unsigned _sp = 0; while (cond) { __builtin_amdgcn_s_sleep(1); \
    if ((++_sp & 255u) == 0u) { if (xb_ld(&(bar)[XB_TMO])) break; if (_sp > XB_SPIN_CAP) { atomicAdd(&(bar)[XB_TMO], 1u); break; } } } } while (0)

struct XcdBarrier {
    unsigned* bar; unsigned x;
    volatile LAS unsigned* st;
};

__device__ __forceinline__ XcdBarrier xcd_barrier_post(unsigned* bar, volatile LAS unsigned* st) {
    XcdBarrier b; b.bar = bar; b.x = xb_xcc_id(); b.st = st;
    if (threadIdx.x == 0) (void)xb_add(&bar[XB_XCNT(b.x)], 1u);
    return b;
}
__device__ __forceinline__ void xcd_barrier_complete(unsigned* bar, unsigned x, unsigned& nloc, unsigned& nx) {
    const unsigned G = gridDim.x * gridDim.y * gridDim.z;
    unsigned sum, cnt, mine, sp = 0u;
    for (;;) {
        sum = 0u; cnt = 0u; mine = 0u;
#pragma unroll
        for (unsigned j = 0; j < 16; ++j) { const unsigned c = xb_ld(&bar[XB_XCNT(j)]); sum += c; cnt += (c > 0u) ? 1u : 0u; mine = (j == x) ? c : mine; }
        if (sum == G) break;
        __builtin_amdgcn_s_sleep(1);
        if ((++sp & 255u) == 0u) { if (xb_ld(&bar[XB_TMO])) break; if (sp > XB_SPIN_CAP) { atomicAdd(&bar[XB_TMO], 1u); break; } }
    }
    nloc = mine > 0u ? mine : 1u; nx = cnt > 0u ? cnt : 1u;
}

__device__ __forceinline__ void xcd_barrier(const XcdBarrier& b) {
    asm volatile("s_waitcnt vmcnt(0)" ::: "memory");
    __syncthreads();
    if (threadIdx.x == 0) {
        unsigned* bar = b.bar;
        __builtin_amdgcn_s_waitcnt(0);
        unsigned nloc = b.st[0], nx = b.st[1];
        if (nloc == 0u) { xcd_barrier_complete(bar, b.x, nloc, nx); b.st[0] = nloc; b.st[1] = nx; }
        const unsigned old = xb_add(&bar[XB_XSUB(b.x)], 1u);
        const unsigned gen = old / nloc;
        if (old + 1u == (gen + 1u) * nloc) {
            __builtin_amdgcn_fence(__ATOMIC_RELEASE, "agent");
            asm volatile("s_waitcnt vmcnt(0)" ::: "memory");
            const unsigned og = xb_add(&bar[XB_TOP], 1u);
            const unsigned tg = og / nx;
            if (og + 1u == (tg + 1u) * nx) xb_add(&bar[XB_TOPGEN], 1u);
            else XB_SPIN(xb_ld(&bar[XB_TOPGEN]) == tg, bar);
            __builtin_amdgcn_fence(__ATOMIC_ACQUIRE, "agent");
            xb_add(&bar[XB_XGEN(b.x)], 1u);
            asm volatile("s_waitcnt vmcnt(0)" ::: "memory");
        } else {
            XB_SPIN(xb_ld(&bar[XB_XGEN(b.x)]) == gen, bar);
            __builtin_amdgcn_fence(__ATOMIC_ACQUIRE, "agent");
            asm volatile("s_waitcnt vmcnt(0)" ::: "memory");
        }
    }
    __syncthreads();
}

constexpr int NWAVES = 8;
constexpr int NB = 8, SEQ = 4096, DM = 1024, MTOK = NB * SEQ, DFF = 4096;
constexpr float LOG2E = 1.4426950408889634f;
constexpr size_t MiB = 1u << 20;
constexpr size_t WS_CTL = 0, CTL_ZERO_BYTES = 1 * MiB;
constexpr size_t WS_WIN0 = 1 * MiB, WS_WGLU = 5 * MiB, WS_WOUT0 = 6 * MiB, WS_WUP0 = 8 * MiB, WS_WDN0 = 16 * MiB, WS_WIN1 = 24 * MiB, WS_WOUT1 = 31 * MiB, WS_WUP1 = 33 * MiB, WS_WDN1 = 41 * MiB;
constexpr size_t WS_SSP = 49 * MiB;
constexpr size_t WS_LOGF = 51 * MiB;
constexpr size_t WS_CB = 52 * MiB;
constexpr size_t WS_ROT = 53 * MiB;
constexpr size_t WS_XB = 64 * MiB;
constexpr size_t WS_BIG = 128 * MiB;
constexpr size_t WS_Q = 128 * MiB, WS_K = 160 * MiB, WS_V = 192 * MiB, WS_U = 224 * MiB, WS_YG = 256 * MiB, WS_MIX = 288 * MiB;
constexpr size_t WS_P1 = 128 * MiB;
constexpr size_t WS_MIX1 = 352 * MiB;
constexpr size_t WS_KV = 416 * MiB;
constexpr size_t WS_S4A = 480 * MiB;
constexpr size_t WS_END = 496 * MiB;
constexpr size_t P1_STRIDE = 32 * MiB / 2;
constexpr int CW_TMO = 0, CW_CODE = 1, CW_BAR = 4096;
constexpr int RING_OFF = 0, RING_BYTES = 131072;
constexpr int LDSCTL_OFF = RING_BYTES, MISC_OFF = LDSCTL_OFF + 320;
constexpr int LDS_BYTES = 147456;


struct Frame {
    LAS unsigned char* lds;
    volatile LAS unsigned* MISC;
    gu32* ctl;
    int tid, lane, wave;
    int vcu, G;
};
struct Args { const float* in[23]; float* out; unsigned char* ws; int ph_lo, ph_hi, li, pad; };

__device__ __forceinline__ float wave_sum(float v) {
#pragma unroll
    for (int o = 1; o < 64; o <<= 1) v += __shfl_xor(v, o);
    return v;
}
__device__ __forceinline__ float bf2f(unsigned short u) { return __uint_as_float((unsigned)u << 16); }

__device__ __forceinline__ void p0_transpose_item(const float* W, int ldw, int scol, int K, int ncols, bf16* WT, int drow, const float* gain, float scale, LAS float* scr, int item, int lane) {
    const int nblk = ncols / 32, kb = item / nblk, nb = item % nblk, k0 = 64 * kb, n0 = 32 * nb;
#pragma unroll 8
    for (int i = 0; i < 32; ++i) { const int kk = 2 * i + (lane >> 5); float v = W[(size_t)(k0 + kk) * ldw + scol + n0 + (lane & 31)]; if (gain) v *= gain[k0 + kk]; scr[kk * 33 + (lane & 31)] = v * scale; }
    LDS_WAIT(); asm volatile("" ::: "memory");
    const int c = lane & 7;
#pragma unroll
    for (int j = 0; j < 4; ++j) { const int n = (lane >> 3) + 8 * j; const LAS float* s = scr + (8 * c) * 33 + n;
        v4u o; o.x = pk2(s[0 * 33], s[1 * 33]); o.y = pk2(s[2 * 33], s[3 * 33]); o.z = pk2(s[4 * 33], s[5 * 33]); o.w = pk2(s[6 * 33], s[7 * 33]);
        *(GAS v4u*)(WT + (size_t)(drow + n0 + n) * K + k0 + 8 * c) = o; }
    LDS_WAIT(); asm volatile("" ::: "memory");
}
__device__ __forceinline__ void rot_entry(int pos, int f, float& co, float& si) {
    const double inv = exp2(-(double)f * (13.287712379549449 / 63.0));
    const double ang = (double)pos * inv;
    const double twopi = 6.283185307179586476925, hp = 1.5707963267948966192;
    const double r = ang - twopi * rint(ang / twopi);
    const double kq = rint(r / hp), t = r - kq * hp, t2 = t * t;
    double sp = 1.0 / 6227020800.0; sp = sp * t2 - 1.0 / 39916800.0; sp = sp * t2 + 1.0 / 362880.0; sp = sp * t2 - 1.0 / 5040.0; sp = sp * t2 + 1.0 / 120.0; sp = sp * t2 - 1.0 / 6.0; sp = sp * t2 + 1.0; sp *= t;
    double cp = -1.0 / 87178291200.0; cp = cp * t2 + 1.0 / 479001600.0; cp = cp * t2 - 1.0 / 3628800.0; cp = cp * t2 + 1.0 / 40320.0; cp = cp * t2 - 1.0 / 720.0; cp = cp * t2 + 1.0 / 24.0; cp = cp * t2 - 0.5; cp = cp * t2 + 1.0;
    const int qd = ((int)kq) & 3; double s, c;
    if (qd == 0) { s = sp; c = cp; } else if (qd == 1) { s = cp; c = -sp; } else if (qd == 2) { s = -sp; c = -cp; } else { s = -cp; c = sp; }
    co = (float)c; si = (float)s;
}
__device__ __forceinline__ void p0_prologue(Frame& F, const Args& A) {
    unsigned char* ws = A.ws;
    const float* x = A.in[0]; const float* even_norm = A.in[1]; const float* even_w_in = A.in[2]; const float* even_bf = A.in[3];
    const float* w_glu = A.in[12]; const float* even_w_out = A.in[14]; const float* odd_norm = A.in[15]; const float* odd_w_in = A.in[16]; const float* odd_w_out = A.in[18];
    const float* mlp_norm = A.in[19]; const float* w_up = A.in[20]; const float* w_dn = A.in[21];
    LAS float* scr = (LAS float*)(F.lds + RING_OFF + F.wave * 9216);
    LAS float* GWs = (LAS float*)(F.lds + RING_OFF + 98304);
    const int gw = F.vcu * NWAVES + F.wave, NGW = F.G * NWAVES;
    for (int i = F.tid; i < 8192; i += NWAVES * 64) { const int h = i >> 10, k = i & 1023; GWs[i] = even_norm[k] * even_w_in[(size_t)k * 2056 + 1536 + h]; }
    constexpr int NITEMS = 12160;
    const float C2 = 0.125f * LOG2E, KS = 0.08838834764831845f;
    for (int it = gw; it < NITEMS; it += NGW) {
        int r = it;
#define SEG(cnt, W, ldw, scol, K, ncols, WT, drow, gain, scale) if (r < (cnt)) { p0_transpose_item(W, ldw, scol, K, ncols, (bf16*)(ws + (WT)), drow, gain, scale, scr, r, F.lane); continue; } r -= (cnt);
        SEG(256, even_w_in, 2056, 0, 1024, 512, WS_WIN0, 0, even_norm, C2)
        SEG(512, even_w_in, 2056, 512, 1024, 1024, WS_WIN0, 512, even_norm, 1.0f)
        SEG(256, even_w_in, 2056, 1544, 1024, 512, WS_WIN0, 1536, even_norm, 1.0f)
        SEG(128, w_glu, 512, 0, 512, 512, WS_WGLU, 0, nullptr, 1.0f)
        SEG(512, even_w_out, 1024, 0, 1024, 1024, WS_WOUT0, 0, nullptr, 1.0f)
        SEG(2048, w_up, 4096, 0, 1024, 4096, WS_WUP0, 0, mlp_norm, 1.0f)
        SEG(2048, w_dn, 1024, 0, 4096, 1024, WS_WDN0, 0, nullptr, 1.0f)
        SEG(1024, odd_w_in, 3584, 0, 1024, 2048, WS_WIN1, 0, odd_norm, 1.0f)
        SEG(256, odd_w_in, 3584, 2048, 1024, 512, WS_WIN1, 2048, odd_norm, KS)
        SEG(512, odd_w_in, 3584, 2560, 1024, 1024, WS_WIN1, 2560, odd_norm, 1.0f)
        SEG(512, odd_w_out, 1024, 0, 1024, 1024, WS_WOUT1, 0, nullptr, 1.0f)
        SEG(2048, w_up + (size_t)1024 * 4096, 4096, 0, 1024, 4096, WS_WUP1, 0, mlp_norm + 1024, 1.0f)
        SEG(2048, w_dn + (size_t)4096 * 1024, 1024, 0, 4096, 1024, WS_WDN1, 0, nullptr, 1.0f)
#undef SEG
    }
    { float* rot = (float*)(ws + WS_ROT);
      for (int i = F.vcu * (NWAVES * 64) + F.tid; i < SEQ * 64; i += F.G * NWAVES * 64) { float c, s; rot_entry(i >> 6, i & 63, c, s); *(float2*)(rot + 2 * (size_t)i) = make_float2(c, s); } }
    LDS_WAIT(); __syncthreads();
    bf16* XB = (bf16*)(ws + WS_XB); float* SSP = (float*)(ws + WS_SSP); float* LOGF = (float*)(ws + WS_LOGF);
    for (int m = gw; m < MTOK; m += NGW) {
        const GAS f32x4* xr = (const GAS f32x4*)(x + (size_t)m * DM) + F.lane;
        f32x4 v[4]; float ss = 0.f;
#pragma unroll
        for (int j = 0; j < 4; ++j) { v[j] = xr[64 * j]; ss += (v[j].x * v[j].x + v[j].y * v[j].y) + (v[j].z * v[j].z + v[j].w * v[j].w); }
        GAS unsigned long long* o8 = (GAS unsigned long long*)(XB + (size_t)m * DM) + F.lane;
#pragma unroll
        for (int j = 0; j < 4; ++j) o8[64 * j] = (unsigned long long)pk2(v[j].x, v[j].y) | ((unsigned long long)pk2(v[j].z, v[j].w) << 32);
        float fa[8];
#pragma unroll
        for (int h = 0; h < 8; ++h) { float a = 0.f;
#pragma unroll
            for (int j = 0; j < 4; ++j) { const f32x4 g4 = *(const LAS f32x4*)(GWs + h * 1024 + 256 * j + 4 * F.lane); a += (v[j].x * g4.x + v[j].y * g4.y) + (v[j].z * g4.z + v[j].w * g4.w); }
            fa[h] = wave_sum(a); }
        ss = wave_sum(ss);
        const float rstd = 1.0f / sqrtf(ss * (1.0f / DM) + 1e-6f);
        float z = 0.f;
#pragma unroll
        for (int h = 0; h < 8; ++h) if (F.lane == h) z = fa[h];
        if (F.lane < 8) { z = z * rstd + even_bf[F.lane];
            const float r = (z > 0.f) ? -log1pf(expf(-z)) : (z - log1pf(expf(z)));
            LOGF[((size_t)((m >> 12) * 8 + F.lane)) * SEQ + (m & 4095)] = r; }
        if (F.lane == 0) SSP[(size_t)m * 16] = ss;
    }
}
__device__ __forceinline__ void p1_cumsum(Frame& F, const Args& A, int bh) {
    const float* src = (const float*)(A.ws + WS_LOGF) + (size_t)bh * SEQ + F.tid * 8;
    float* dst = (float*)(A.ws + WS_CB) + (size_t)bh * SEQ + F.tid * 8;
    LAS float* wsum = (LAS float*)(F.lds + RING_OFF);
    const f32x4 a = *(const f32x4*)src, b = *(const f32x4*)(src + 4);
    float v[8] = {a.x, a.y, a.z, a.w, b.x, b.y, b.z, b.w};
#pragma unroll
    for (int i = 1; i < 8; ++i) v[i] += v[i - 1];
    const float tot = v[7]; float inc = tot;
#pragma unroll
    for (int o = 1; o < 64; o <<= 1) { const float t = __shfl_up(inc, o); if (F.lane >= o) inc += t; }
    if (F.lane == 63) wsum[F.wave] = inc;
    LDS_WAIT(); __syncthreads();
    float base = inc - tot;
#pragma unroll
    for (int w = 0; w < NWAVES; ++w) if (w < F.wave) base += wsum[w];
    f32x4 o0, o1;
    o0.x = (v[0] + base) * LOG2E; o0.y = (v[1] + base) * LOG2E; o0.z = (v[2] + base) * LOG2E; o0.w = (v[3] + base) * LOG2E;
    o1.x = (v[4] + base) * LOG2E; o1.y = (v[5] + base) * LOG2E; o1.z = (v[6] + base) * LOG2E; o1.w = (v[7] + base) * LOG2E;
    *(f32x4*)dst = o0; *(f32x4*)(dst + 4) = o1;
    LDS_WAIT(); __syncthreads();
}
__device__ __forceinline__ void p_final(Frame& F, const Args& A) {
    const int gw = F.vcu * NWAVES + F.wave, NGW = F.G * NWAVES;
    const float* g = A.in[22]; const bf16* XB = (const bf16*)(A.ws + WS_XB);
    f32x4 gg[4];
#pragma unroll
    for (int j = 0; j < 4; ++j) gg[j] = ((const f32x4*)g)[F.lane + 64 * j];
    for (int m = gw; m < MTOK; m += NGW) {
        const GAS unsigned long long* xr = (const GAS unsigned long long*)(XB + (size_t)m * DM) + F.lane;
        f32x4 v[4]; float ss = 0.f;
#pragma unroll
        for (int j = 0; j < 4; ++j) { const unsigned long long w = xr[64 * j]; const unsigned lo = (unsigned)w, hi = (unsigned)(w >> 32);
            v[j] = (f32x4){__uint_as_float(lo << 16), __uint_as_float(lo & 0xffff0000u), __uint_as_float(hi << 16), __uint_as_float(hi & 0xffff0000u)};
            ss += (v[j].x * v[j].x + v[j].y * v[j].y) + (v[j].z * v[j].z + v[j].w * v[j].w); }
        ss = wave_sum(ss);
        const float r = 1.0f / sqrtf(ss * (1.0f / DM) + 1e-6f);
        GAS f32x4* o = (GAS f32x4*)(A.out + (size_t)m * DM) + F.lane;
#pragma unroll
        for (int j = 0; j < 4; ++j) o[64 * j] = v[j] * r * gg[j];
    }
}

__device__ __forceinline__ float gelu_tanh_fast(float x) { const float u = 0.7978845608028654f * (x + 0.044715f * x * x * x); return x / (1.0f + __expf(-2.0f * u)); }
__device__ __forceinline__ void s5_lambar(float lr, float li, float dt, float& lbr, float& lbi) { const float er = expf(lr * dt); float sn, cs; sincosf(li * dt, &sn, &cs); lbr = er * cs; lbi = er * sn; }
template <bool PASS2>
__device__ __forceinline__ void s5_pass(const unsigned short* U, unsigned short* YG, size_t row0, int g, LAS float* BUs, LAS unsigned* Xs, const pg8::bf16x8 (&Bf)[8], const pg8::bf16x8 (&Cf)[4], const pg8::bf16x8& Df,
                                        float lbr, float lbi, float& xr, float& xi, int lane) {
    typedef float f32x2 __attribute__((ext_vector_type(2)));
    const int c16 = lane & 15, kq = lane >> 4;
    const pg8::bf16x8 zero8 = {0, 0, 0, 0, 0, 0, 0, 0};
    pg8::bf16x8 an = zero8;
    if (kq < 2) an = *(const pg8::bf16x8*)(U + (row0 + c16) * 512 + g * 16 + 8 * kq);
    for (int sc = 0; sc < 32; ++sc) {
        const size_t r0 = row0 + 16 * sc;
        const pg8::bf16x8 a = an;
        if (sc + 1 < 32) { if (kq < 2) an = *(const pg8::bf16x8*)(U + (r0 + 16 + c16) * 512 + g * 16 + 8 * kq); }
        unsigned short uw[4];
        if (PASS2) {
#pragma unroll
            for (int r = 0; r < 4; ++r) uw[r] = U[(r0 + 4 * kq + r) * 512 + g * 16 + c16]; }
#pragma unroll
        for (int nb = 0; nb < 8; ++nb) {
            pg8::f32x4 d = {0.f, 0.f, 0.f, 0.f};
            d = __builtin_amdgcn_mfma_f32_16x16x32_bf16(a, Bf[nb], d, 0, 0, 0);
#pragma unroll
            for (int r = 0; r < 4; ++r) BUs[(4 * kq + r) * 128 + 16 * nb + c16] = d[r];
        }
        f32x2 bu[16];
#pragma unroll
        for (int t = 0; t < 16; ++t) bu[t] = *(const LAS f32x2*)(BUs + t * 128 + 2 * lane);
        asm volatile("s_waitcnt lgkmcnt(0)" ::: "memory");
#pragma unroll
        for (int t = 0; t < 16; ++t) {
            const float nxr = lbr * xr - lbi * xi + bu[t].x, nxi = lbr * xi + lbi * xr + bu[t].y;
            xr = nxr; xi = nxi;
            if (PASS2) Xs[t * 64 + lane] = pg8::cvt_pk_bf16(xr, xi);
        }
        if (PASS2) {
            pg8::f32x4 y = {0.f, 0.f, 0.f, 0.f};
            y = __builtin_amdgcn_mfma_f32_16x16x32_bf16(a, Df, y, 0, 0, 0);
#pragma unroll
            for (int ks = 0; ks < 4; ++ks) { const pg8::bf16x8 xa = *(const LAS pg8::bf16x8*)((const LAS unsigned short*)Xs + c16 * 128 + 32 * ks + 8 * kq); y = __builtin_amdgcn_mfma_f32_16x16x32_bf16(xa, Cf[ks], y, 0, 0, 0); }
#pragma unroll
            for (int r = 0; r < 4; ++r) { const size_t m = r0 + 4 * kq + r; YG[m * 512 + g * 16 + c16] = (unsigned short)f2bf(gelu_tanh_fast(y[r])); }
        }
    }
}
__device__ __forceinline__ void s5_unit(Frame& F, const Args& A, int b, int g) {
    typedef float f32x2 __attribute__((ext_vector_type(2)));
    const int lane = F.lane, w = F.wave, c16 = lane & 15, kq = lane >> 4;
    const float* log_dt = A.in[4]; const float* lam_re = A.in[5]; const float* lam_im = A.in[6]; const float* b_re = A.in[7]; const float* b_im = A.in[8];
    const float* c_re = A.in[9]; const float* c_im = A.in[10]; const float* d_skip = A.in[11];
    const unsigned short* U = (const unsigned short*)(A.ws + WS_U); unsigned short* YG = (unsigned short*)(A.ws + WS_YG);
    LAS float* BUs = (LAS float*)(F.lds + RING_OFF + w * 12288);
    LAS unsigned* Xs = (LAS unsigned*)(F.lds + RING_OFF + w * 12288 + 8192);
    LAS f32x2* Es = (LAS f32x2*)(F.lds + RING_OFF + 98304);
    const float dt = expf(log_dt[g]);
    float lbr, lbi; s5_lambar(lam_re[g * 64 + lane], lam_im[g * 64 + lane], dt, lbr, lbi);
    pg8::bf16x8 Bf[8], Cf[4];
#pragma unroll
    for (int nb = 0; nb < 8; ++nb) {
        const int comp = 16 * nb + c16, pp = comp >> 1, im = comp & 1;
        const float lr = lam_re[g * 64 + pp], li = lam_im[g * 64 + pp]; float pr, pi; s5_lambar(lr, li, dt, pr, pi);
        const float nr = pr - 1.0f, ni = pi, den = lr * lr + li * li, cr = (nr * lr + ni * li) / den, ci = (ni * lr - nr * li) / den;
#pragma unroll
        for (int j = 0; j < 8; ++j) { float val = 0.f;
            if (kq < 2) { const int h = 8 * kq + j; const float br = b_re[(g * 64 + pp) * 16 + h], bi = b_im[(g * 64 + pp) * 16 + h]; val = im ? (cr * bi + ci * br) : (cr * br - ci * bi); }
            Bf[nb][j] = (short)f2bf(val); }
    }
#pragma unroll
    for (int ks = 0; ks < 4; ++ks)
#pragma unroll
        for (int j = 0; j < 8; ++j) { const int comp = 32 * ks + 8 * kq + j, pp = comp >> 1, im = comp & 1;
            const float val = im ? -c_im[(g * 16 + c16) * 64 + pp] : c_re[(g * 16 + c16) * 64 + pp]; Cf[ks][j] = (short)f2bf(val); }
    pg8::bf16x8 Df;
#pragma unroll
    for (int j = 0; j < 8; ++j) Df[j] = (short)((kq < 2 && 8 * kq + j == c16) ? f2bf(d_skip[g * 16 + c16]) : 0u);
    const size_t row0 = (size_t)b * SEQ + (size_t)w * 512;
    float xr = 0.f, xi = 0.f;
    s5_pass<false>(U, YG, row0, g, BUs, Xs, Bf, Cf, Df, lbr, lbi, xr, xi, lane);
    Es[w * 64 + lane] = (f32x2){xr, xi};
    LDS_WAIT(); __syncthreads();
    float pr = lbr, pi = lbi;
#pragma unroll
    for (int i = 0; i < 9; ++i) { const float t = pr * pr - pi * pi; pi = 2.0f * pr * pi; pr = t; }
    xr = 0.f; xi = 0.f;
    for (int v = 0; v < w; ++v) { const f32x2 e = Es[v * 64 + lane]; const float nr = pr * xr - pi * xi + e.x, ni = pr * xi + pi * xr + e.y; xr = nr; xi = ni; }
    s5_pass<true>(U, YG, row0, g, BUs, Xs, Bf, Cf, Df, lbr, lbi, xr, xi, lane);
    LDS_WAIT(); __syncthreads();
}

typedef float f32x16 __attribute__((ext_vector_type(16)));
constexpr int RT_PITCH = 136;
__device__ __forceinline__ int crow16(int r, int hi) { return (r & 3) + 8 * (r >> 2) + 4 * hi; }
__device__ __forceinline__ float ret_log2gamma(int h) { return log2f(1.0f - exp2f(-5.0f - (float)h)); }
__device__ __forceinline__ pg8::bf16x8 gather8(const LAS unsigned short* p, int o0, int o1, int o2, int o3, int o4, int o5, int o6, int o7) {
    pg8::bf16x8 f; f[0] = (short)p[o0]; f[1] = (short)p[o1]; f[2] = (short)p[o2]; f[3] = (short)p[o3]; f[4] = (short)p[o4]; f[5] = (short)p[o5]; f[6] = (short)p[o6]; f[7] = (short)p[o7]; return f; }

__device__ __forceinline__ void conv_phase(Frame& F, const Args& A) {
    const unsigned short* HC = (const unsigned short*)(A.ws + WS_P1); const unsigned short* GB = HC + P1_STRIDE; const unsigned short* GC = HC + 2 * P1_STRIDE;
    unsigned short* MIX1 = (unsigned short*)(A.ws + WS_MIX1); const float* cw = A.in[17];
    for (int it = F.vcu * (NWAVES * 64) + F.tid; it < (MTOK / 16) * 64; it += F.G * NWAVES * 64) {
        const int cg = it & 63, run = it >> 6, c0 = cg * 8; const size_t m0 = (size_t)run * 16; const int l0 = (int)(m0 & 4095);
        float w0[8], w1[8], w2[8], z1[8], z2[8];
#pragma unroll
        for (int e = 0; e < 8; ++e) { w0[e] = cw[c0 + e]; w1[e] = cw[512 + c0 + e]; w2[e] = cw[1024 + c0 + e]; z1[e] = 0.f; z2[e] = 0.f; }
        if (l0 > 0) {
            const v4u h1 = *(const v4u*)(HC + (m0 - 1) * 512 + c0), g1 = *(const v4u*)(GC + (m0 - 1) * 512 + c0), h2 = *(const v4u*)(HC + (m0 - 2) * 512 + c0), g2 = *(const v4u*)(GC + (m0 - 2) * 512 + c0);
#pragma unroll
            for (int e = 0; e < 4; ++e) { z1[2 * e] = __uint_as_float(h1[e] << 16) * __uint_as_float(g1[e] << 16); z1[2 * e + 1] = __uint_as_float(h1[e] & 0xffff0000u) * __uint_as_float(g1[e] & 0xffff0000u);
                z2[2 * e] = __uint_as_float(h2[e] << 16) * __uint_as_float(g2[e] << 16); z2[2 * e + 1] = __uint_as_float(h2[e] & 0xffff0000u) * __uint_as_float(g2[e] & 0xffff0000u); }
        }
        for (int t = 0; t < 16; ++t) {
            const size_t m = m0 + t;
            const v4u hh = *(const v4u*)(HC + m * 512 + c0), gc = *(const v4u*)(GC + m * 512 + c0), gb = *(const v4u*)(GB + m * 512 + c0);
            float z[8], o[8];
#pragma unroll
            for (int e = 0; e < 4; ++e) { z[2 * e] = __uint_as_float(hh[e] << 16) * __uint_as_float(gc[e] << 16); z[2 * e + 1] = __uint_as_float(hh[e] & 0xffff0000u) * __uint_as_float(gc[e] & 0xffff0000u); }
#pragma unroll
            for (int e = 0; e < 8; ++e) { const float y = w0[e] * z2[e] + w1[e] * z1[e] + w2[e] * z[e]; const float gbv = (e & 1) ? __uint_as_float(gb[e >> 1] & 0xffff0000u) : __uint_as_float(gb[e >> 1] << 16); o[e] = gbv * y; z2[e] = z1[e]; z1[e] = z[e]; }
            v4u ow; ow.x = pk2(o[0], o[1]); ow.y = pk2(o[2], o[3]); ow.z = pk2(o[4], o[5]); ow.w = pk2(o[6], o[7]);
            *(v4u*)(MIX1 + m * 1024 + c0) = ow;
        }
    }
}
__device__ __forceinline__ void ret_stage_tile(Frame& F, const unsigned short* src, size_t t0, int col0, LAS unsigned short* dst, bool decay, float lg) {
#pragma unroll
    for (int i = 0; i < 4; ++i) { const int f = F.tid + 512 * i, row = f >> 4, cq = (f & 15) * 8;
        v4u v = *(const v4u*)(src + (t0 + row) * 512 + col0 + cq);
        if (decay) { const float s = exp2f(lg * (float)(127 - row));
#pragma unroll
            for (int e = 0; e < 4; ++e) v[e] = pk2(__uint_as_float(v[e] << 16) * s, __uint_as_float(v[e] & 0xffff0000u) * s); }
        *(LAS v4u*)(dst + row * RT_PITCH + cq) = v; }
}
__device__ __forceinline__ void ret_kv_unit(Frame& F, const Args& A, int u) {
    const int b = u >> 5, h = (u >> 3) & 3, a = u & 7, lane = F.lane, w = F.wave, l31 = lane & 31, hi = lane >> 5;
    const unsigned short* RK = (const unsigned short*)(A.ws + WS_P1) + 4 * P1_STRIDE; const unsigned short* RV = (const unsigned short*)(A.ws + WS_P1) + 5 * P1_STRIDE;
    float* PT = (float*)(A.ws + WS_KV) + (size_t)u * 4 * 16384;
    LAS unsigned short* Ks = (LAS unsigned short*)(F.lds + RING_OFF); LAS unsigned short* Vs = Ks + 128 * RT_PITCH;
    const float lg = ret_log2gamma(h), g128 = exp2f(lg * 128.0f);
    const int vb = w >> 1, db0 = 2 * (w & 1);
    f32x16 acc[2]; acc[0] = f32x16{}; acc[1] = f32x16{};
    for (int r = 0; r < 4; ++r) {
        const size_t t0 = (size_t)b * SEQ + (size_t)(4 * a + r) * 128;
        __syncthreads();
        ret_stage_tile(F, RK, t0, h * 128, Ks, true, lg); ret_stage_tile(F, RV, t0, h * 128, Vs, false, 0.f);
        LDS_WAIT(); __syncthreads();
        if (r > 0) {
#pragma unroll
            for (int j = 0; j < 2; ++j)
#pragma unroll
                for (int q = 0; q < 16; ++q) PT[(size_t)r * 16384 + (vb * 32 + crow16(q, hi)) * 128 + (db0 + j) * 32 + l31] = acc[j][q];
        }
#pragma unroll
        for (int j = 0; j < 2; ++j) acc[j] = acc[j] * g128;
#pragma unroll
        for (int ks = 0; ks < 8; ++ks) {
            const int tk = 16 * ks + 8 * hi;
            const LAS unsigned short* vp = Vs + tk * RT_PITCH + vb * 32 + l31;
            const pg8::bf16x8 af = gather8(vp, 0, RT_PITCH, 2 * RT_PITCH, 3 * RT_PITCH, 4 * RT_PITCH, 5 * RT_PITCH, 6 * RT_PITCH, 7 * RT_PITCH);
#pragma unroll
            for (int j = 0; j < 2; ++j) { const LAS unsigned short* kp = Ks + tk * RT_PITCH + (db0 + j) * 32 + l31;
                const pg8::bf16x8 bfr = gather8(kp, 0, RT_PITCH, 2 * RT_PITCH, 3 * RT_PITCH, 4 * RT_PITCH, 5 * RT_PITCH, 6 * RT_PITCH, 7 * RT_PITCH);
                acc[j] = __builtin_amdgcn_mfma_f32_32x32x16_bf16(af, bfr, acc[j], 0, 0, 0); }
        }
    }
#pragma unroll
    for (int j = 0; j < 2; ++j)
#pragma unroll
        for (int q = 0; q < 16; ++q) PT[(vb * 32 + crow16(q, hi)) * 128 + (db0 + j) * 32 + l31] = acc[j][q];
    __syncthreads();
}
__device__ __forceinline__ void ret_out_group(Frame& F, const Args& A, int gidx) {
    const int b = gidx >> 5, h = (gidx >> 3) & 3, a = gidx & 7, lane = F.lane, w = F.wave, l31 = lane & 31, hi = lane >> 5;
    const unsigned short* RQ = (const unsigned short*)(A.ws + WS_P1) + 3 * P1_STRIDE; const unsigned short* RK = RQ + P1_STRIDE; const unsigned short* RV = RQ + 2 * P1_STRIDE; const unsigned short* RG = RQ + 3 * P1_STRIDE;
    unsigned short* MIX1 = (unsigned short*)(A.ws + WS_MIX1);
    const float* PTg = (const float*)(A.ws + WS_KV) + (size_t)((b * 4 + h) * 8) * 4 * 16384;
    LAS unsigned short* Ss = (LAS unsigned short*)(F.lds + RING_OFF); LAS unsigned short* Vs = Ss + 128 * RT_PITCH; LAS unsigned short* Ks = Vs + 128 * RT_PITCH; LAS float* GN = (LAS float*)(F.lds + RING_OFF + 3 * 128 * RT_PITCH * 2);
    const float lg = ret_log2gamma(h);
    f32x4 s4[8];
#pragma unroll
    for (int k = 0; k < 8; ++k) s4[k] = (f32x4){0.f, 0.f, 0.f, 0.f};
    for (int ap = 0; ap < a; ++ap) { const float cf = exp2f(lg * 512.0f * (float)(a - 1 - ap)); const f32x4* T = (const f32x4*)(PTg + (size_t)ap * 4 * 16384);
#pragma unroll
        for (int k = 0; k < 8; ++k) s4[k] += T[F.tid + 512 * k] * cf; }
    f32x4* S4A = (f32x4*)(A.ws + WS_S4A) + (size_t)gidx * 4096;
#pragma unroll
    for (int k = 0; k < 8; ++k) S4A[F.tid + 512 * k] = s4[k];
    VM_WAIT(); __syncthreads();
    const int qb = w & 3, vh = w >> 2, qpos = 32 * qb + l31;
    for (int r = 0; r < 4; ++r) {
        const int i = 4 * a + r; const size_t t0 = (size_t)b * SEQ + (size_t)i * 128;
        const float gr = exp2f(lg * 128.0f * (float)r);
        f32x4 pr[8];
        if (r > 0) { const f32x4* P = (const f32x4*)(PTg + (size_t)a * 4 * 16384 + (size_t)r * 16384);
#pragma unroll
            for (int k = 0; k < 8; ++k) pr[k] = S4A[F.tid + 512 * k] * gr + P[F.tid + 512 * k]; }
        else {
#pragma unroll
            for (int k = 0; k < 8; ++k) pr[k] = S4A[F.tid + 512 * k]; }
        __syncthreads();
#pragma unroll
        for (int k = 0; k < 8; ++k) { const int e = 4 * (F.tid + 512 * k); const f32x4 v = pr[k];
            pg8::u32x2 o; o.x = pk2(v[0], v[1]); o.y = pk2(v[2], v[3]); *(LAS pg8::u32x2*)(Ss + (e >> 7) * RT_PITCH + (e & 127)) = o; }
        ret_stage_tile(F, RV, t0, h * 128, Vs, false, 0.f); ret_stage_tile(F, RK, t0, h * 128, Ks, false, 0.f);
        pg8::bf16x8 qf[8];
#pragma unroll
        for (int ks = 0; ks < 8; ++ks) qf[ks] = *(const pg8::bf16x8*)(RQ + (t0 + 32 * qb + l31) * 512 + h * 128 + 16 * ks + 8 * hi);
        LDS_WAIT(); __syncthreads();
        f32x16 inner[2], cross[2]; inner[0] = f32x16{}; inner[1] = f32x16{}; cross[0] = f32x16{}; cross[1] = f32x16{};
        for (int sb = 0; sb <= qb; ++sb) {
            f32x16 st = f32x16{};
#pragma unroll
            for (int ks = 0; ks < 8; ++ks) { const pg8::bf16x8 kf = *(const LAS pg8::bf16x8*)(Ks + (32 * sb + l31) * RT_PITCH + 16 * ks + 8 * hi); st = __builtin_amdgcn_mfma_f32_32x32x16_bf16(kf, qf[ks], st, 0, 0, 0); }
#pragma unroll
            for (int q = 0; q < 16; ++q) { const int sp = 32 * sb + crow16(q, hi); const int dlt = qpos - sp; st[q] = (dlt >= 0) ? st[q] * exp2f(lg * (float)dlt) : 0.f; }
#pragma unroll
            for (int s2 = 0; s2 < 2; ++s2) {
                pg8::bf16x8 af; { const unsigned a0 = pg8::cvt_pk_bf16(st[8 * s2], st[8 * s2 + 1]), a1 = pg8::cvt_pk_bf16(st[8 * s2 + 2], st[8 * s2 + 3]), a2 = pg8::cvt_pk_bf16(st[8 * s2 + 4], st[8 * s2 + 5]), a3 = pg8::cvt_pk_bf16(st[8 * s2 + 6], st[8 * s2 + 7]);
                    const pg8::u32x4 aw = {a0, a1, a2, a3}; af = __builtin_bit_cast(pg8::bf16x8, aw); }
                const int srow = 32 * sb + 16 * s2 + 4 * hi;
#pragma unroll
                for (int j = 0; j < 2; ++j) { const LAS unsigned short* vp = Vs + srow * RT_PITCH + vh * 64 + j * 32 + l31;
                    const pg8::bf16x8 bfr = gather8(vp, 0, RT_PITCH, 2 * RT_PITCH, 3 * RT_PITCH, 8 * RT_PITCH, 9 * RT_PITCH, 10 * RT_PITCH, 11 * RT_PITCH);
                    inner[j] = __builtin_amdgcn_mfma_f32_32x32x16_bf16(bfr, af, inner[j], 0, 0, 0); }
            }
        }
#pragma unroll
        for (int ks = 0; ks < 8; ++ks)
#pragma unroll
            for (int j = 0; j < 2; ++j) { const pg8::bf16x8 sf = *(const LAS pg8::bf16x8*)(Ss + (vh * 64 + j * 32 + l31) * RT_PITCH + 16 * ks + 8 * hi); cross[j] = __builtin_amdgcn_mfma_f32_32x32x16_bf16(sf, qf[ks], cross[j], 0, 0, 0); }
        const size_t mrow = t0 + 32 * qb + l31;
        const unsigned short* rgp = RG + mrow * 512 + h * 128 + vh * 64 + 4 * hi;
        unsigned short* mxp = MIX1 + mrow * 1024 + 512 + h * 128 + vh * 64 + 4 * hi;
        pg8::u32x2 gw[2][4];
#pragma unroll
        for (int j = 0; j < 2; ++j)
#pragma unroll
            for (int g4 = 0; g4 < 4; ++g4) gw[j][g4] = *(const pg8::u32x2*)(rgp + j * 32 + 8 * g4);
        const float qd = exp2f(lg * (float)(qpos + 1));
        float s = 0.f, q2 = 0.f;
#pragma unroll
        for (int j = 0; j < 2; ++j)
#pragma unroll
            for (int e = 0; e < 16; ++e) { const float o = inner[j][e] + qd * cross[j][e]; inner[j][e] = o; s += o; q2 += o * o; }
        { auto r0_ = __builtin_amdgcn_permlane32_swap(__float_as_uint(s), __float_as_uint(s), false, false); s = __uint_as_float(r0_[0]) + __uint_as_float(r0_[1]);
          auto r1_ = __builtin_amdgcn_permlane32_swap(__float_as_uint(q2), __float_as_uint(q2), false, false); q2 = __uint_as_float(r1_[0]) + __uint_as_float(r1_[1]); }
        if (hi == 0) { GN[(qpos * 2 + vh) * 2] = s; GN[(qpos * 2 + vh) * 2 + 1] = q2; }
        LDS_WAIT(); __syncthreads();
        { const float sa = GN[qpos * 4] + GN[qpos * 4 + 2], qa = GN[qpos * 4 + 1] + GN[qpos * 4 + 3];
          const float mu = sa * (1.0f / 128.0f), var = fmaxf(qa * (1.0f / 128.0f) - mu * mu, 0.f), rs = __builtin_amdgcn_rsqf(var + 1e-6f);
#pragma unroll
          for (int j = 0; j < 2; ++j)
#pragma unroll
            for (int g4 = 0; g4 < 4; ++g4) { float o[4];
#pragma unroll
                for (int e = 0; e < 4; ++e) { const unsigned wv = gw[j][g4][e >> 1]; const float gv = (e & 1) ? __uint_as_float(wv & 0xffff0000u) : __uint_as_float(wv << 16);
                    o[e] = gv * __builtin_amdgcn_rcpf(1.0f + __expf(-gv)) * (inner[j][4 * g4 + e] - mu) * rs; }
                pg8::u32x2 ow; ow.x = pg8::cvt_pk_bf16(o[0], o[1]); ow.y = pg8::cvt_pk_bf16(o[2], o[3]);
                *(pg8::u32x2*)(mxp + j * 32 + 8 * g4) = ow; } }
    }
    __syncthreads();
}
#ifndef REP_MASK
#define REP_MASK 0
#endif
#define NREP(k) ((((REP_MASK) >> (k)) & 1) ? 2 : 1)
__global__ void __launch_bounds__(NWAVES * 64, 2) mk_fwd(Args args) {
    extern __shared__ __attribute__((aligned(16))) unsigned char lds[];
    Frame F;
    F.lds = (LAS unsigned char*)lds;
    F.MISC = (volatile LAS unsigned*)(F.lds + MISC_OFF);
    F.tid = threadIdx.x; F.lane = F.tid & 63; F.wave = __builtin_amdgcn_readfirstlane(F.tid >> 6);
    F.G = gridDim.x; { const int bx = blockIdx.x; F.vcu = (F.G % 8 == 0) ? (bx % 8) * (F.G / 8) + bx / 8 : bx; }
    unsigned char* ws = args.ws;
    F.ctl = (gu32*)(ws + WS_CTL);
    for (int u = F.tid; u < (LDS_BYTES - LDSCTL_OFF) / 4; u += NWAVES * 64) ((LAS unsigned*)(F.lds + LDSCTL_OFF))[u] = 0u;
    __syncthreads();
    const int lo = args.ph_lo, hi = args.ph_hi;
    const bool single = (hi - lo) > 1;
    XcdBarrier bar; bar.bar = (unsigned*)(F.ctl + CW_BAR) + args.li * XCD_BAR_WORDS; bar.x = 0; bar.st = nullptr;
    if (single) bar = xcd_barrier_post((unsigned*)(F.ctl + CW_BAR) + args.li * XCD_BAR_WORDS, F.MISC + 8);
#define IN(k) (lo <= (k) && (k) < hi)
#define BOTH(k) (IN(k) && IN((k) + 1))
#define GRID_BAR() xcd_barrier(bar)
    pg8::bf16_t* XB = (pg8::bf16_t*)(ws + WS_XB);
    float* SSP = (float*)(ws + WS_SSP);
    const float* ROT = (const float*)(ws + WS_ROT);

    if (IN(0)) { for (int rp = 0; rp < NREP(0); ++rp) { p0_prologue(F, args); LDS_WAIT(); __syncthreads(); } if (BOTH(0)) GRID_BAR(); }

    if (IN(1)) {
        if (blockIdx.x < 64) p1_cumsum(F, args, (int)blockIdx.x);
        pg8::Gemm g{XB, (const pg8::bf16_t*)(ws + WS_WIN0), MTOK, 2048, DM}; pg8::StaticOrder S; S.init(MTOK, 2048, F.G, (int)blockIdx.x);
        pg8::EpiRsBf16<0, false> E{(pg8::bf16_t*)(ws + WS_Q), 512, 2, (size_t)(16 * MiB), SSP, 1, nullptr, 0, 0};
        for (int rp = 0; rp < NREP(1); ++rp) pg8::gemm_phase<pg8::EpiRsBf16<0, false>, pg8::StaticOrder, true, true>(F.lds + RING_OFF, g, S, E);
        if (BOTH(1)) GRID_BAR();
    }
    if (IN(2)) {
        for (int rp = 0; rp < NREP(2); ++rp) for (int u = F.vcu; u < 256; u += F.G) s5_unit(F, args, u >> 5, u & 31);
        const attn_body::AttnTensors AT{(const attn_body::bf16*)(ws + WS_Q), (const attn_body::bf16*)(ws + WS_K), (const attn_body::bf16*)(ws + WS_V), (attn_body::bf16*)(ws + WS_MIX), (const float*)(ws + WS_CB)};
        const attn_body::StaticOrder S((int)F.G, (int)blockIdx.x);
        for (int rp = 0; rp < NREP(14); ++rp) attn_body::attn_phase<attn_body::StaticOrder>((char*)lds + RING_OFF, AT, S);
        if (BOTH(2)) GRID_BAR();
    }
    if (IN(3)) {
        pg8::Gemm g{(const pg8::bf16_t*)(ws + WS_YG), (const pg8::bf16_t*)(ws + WS_WGLU), MTOK, 512, 512}; pg8::StaticOrder S; S.init(MTOK, 512, F.G, (int)blockIdx.x);
        pg8::EpiGlu E{(const pg8::bf16_t*)(ws + WS_YG), 512, args.in[13], (pg8::bf16_t*)(ws + WS_MIX), 1024, 512};
        for (int rp = 0; rp < NREP(3); ++rp) pg8::gemm_phase<pg8::EpiGlu, pg8::StaticOrder, true, true>(F.lds + RING_OFF, g, S, E);
        if (BOTH(3)) GRID_BAR();
    }
    if (IN(4)) {
        pg8::Gemm g{(const pg8::bf16_t*)(ws + WS_MIX), (const pg8::bf16_t*)(ws + WS_WOUT0), MTOK, DM, DM}; pg8::StaticOrder S; S.init(MTOK, DM, F.G, (int)blockIdx.x);
        pg8::EpiResid<false> E{args.in[0], nullptr, XB, SSP, DM};
        for (int rp = 0; rp < NREP(4); ++rp) pg8::gemm_phase<pg8::EpiResid<false>, pg8::StaticOrder, true, true>(F.lds + RING_OFF, g, S, E);
        if (BOTH(4)) GRID_BAR();
    }
    if (IN(5)) {
        pg8::Gemm g{XB, (const pg8::bf16_t*)(ws + WS_WUP0), MTOK, DFF, DM}; pg8::StaticOrder S; S.init(MTOK, DFF, F.G, (int)blockIdx.x);
        pg8::EpiRsBf16<1, false> E{(pg8::bf16_t*)(ws + WS_BIG), DFF, 0, 0, SSP, 16, nullptr, 0, 0};
        for (int rp = 0; rp < NREP(5); ++rp) pg8::gemm_phase<pg8::EpiRsBf16<1, false>, pg8::StaticOrder, true, true>(F.lds + RING_OFF, g, S, E);
        if (BOTH(5)) GRID_BAR();
    }
    if (IN(6)) {
        pg8::Gemm g{(const pg8::bf16_t*)(ws + WS_BIG), (const pg8::bf16_t*)(ws + WS_WDN0), MTOK, DM, DFF}; pg8::StaticOrder S; S.init(MTOK, DM, F.G, (int)blockIdx.x);
        pg8::EpiResid<true> E{nullptr, XB, XB, SSP, DM};
        pg8::gemm_phase<pg8::EpiResid<true>, pg8::StaticOrder, true, true>(F.lds + RING_OFF, g, S, E);
        if (BOTH(6)) GRID_BAR();
    }
    if (IN(7)) {
        pg8::Gemm g{XB, (const pg8::bf16_t*)(ws + WS_WIN1), MTOK, 3584, DM}; pg8::StaticOrder S; S.init(MTOK, 3584, F.G, (int)blockIdx.x);
        pg8::EpiRsBf16<0, true> E{(pg8::bf16_t*)(ws + WS_P1), 512, 2, (size_t)(16 * MiB), SSP, 16, ROT, 6, 10};
        for (int rp = 0; rp < NREP(7); ++rp) pg8::gemm_phase<pg8::EpiRsBf16<0, true>, pg8::StaticOrder, true, true>(F.lds + RING_OFF, g, S, E);
        if (BOTH(7)) GRID_BAR();
    }
    if (IN(8)) {
        for (int rp = 0; rp < NREP(8); ++rp) conv_phase(F, args);
        for (int rp = 0; rp < NREP(15); ++rp) for (int u = F.vcu; u < 256; u += F.G) ret_kv_unit(F, args, u);
        if (BOTH(8)) GRID_BAR();
    }
    if (IN(9)) {
        for (int rp = 0; rp < NREP(9); ++rp) for (int u = F.vcu; u < 256; u += F.G) ret_out_group(F, args, u);
        if (BOTH(9)) GRID_BAR();
    }
    if (IN(10)) {
        pg8::Gemm g{(const pg8::bf16_t*)(ws + WS_MIX1), (const pg8::bf16_t*)(ws + WS_WOUT1), MTOK, DM, DM}; pg8::StaticOrder S; S.init(MTOK, DM, F.G, (int)blockIdx.x);
        pg8::EpiResid<true> E{nullptr, XB, XB, SSP, DM};
        pg8::gemm_phase<pg8::EpiResid<true>, pg8::StaticOrder, true, true>(F.lds + RING_OFF, g, S, E);
        if (BOTH(10)) GRID_BAR();
    }
    if (IN(11)) {
        pg8::Gemm g{XB, (const pg8::bf16_t*)(ws + WS_WUP1), MTOK, DFF, DM}; pg8::StaticOrder S; S.init(MTOK, DFF, F.G, (int)blockIdx.x);
        pg8::EpiRsBf16<1, false> E{(pg8::bf16_t*)(ws + WS_BIG), DFF, 0, 0, SSP, 16, nullptr, 0, 0};
        pg8::gemm_phase<pg8::EpiRsBf16<1, false>, pg8::StaticOrder, true, true>(F.lds + RING_OFF, g, S, E);
        if (BOTH(11)) GRID_BAR();
    }
    if (IN(12)) {
        pg8::Gemm g{(const pg8::bf16_t*)(ws + WS_BIG), (const pg8::bf16_t*)(ws + WS_WDN1), MTOK, DM, DFF}; pg8::StaticOrder S; S.init(MTOK, DM, F.G, (int)blockIdx.x);
        pg8::EpiResid<true> E{nullptr, XB, XB, SSP, DM};
        pg8::gemm_phase<pg8::EpiResid<true>, pg8::StaticOrder, true, true>(F.lds + RING_OFF, g, S, E);
        if (BOTH(12)) GRID_BAR();
    }
    if (IN(13)) p_final(F, args);
#undef IN
#undef BOTH
#undef GRID_BAR
}
extern "C" void kernel_launch(void* const* d_in, const int* in_sizes, int n_in, void* d_out, int out_size, void* d_ws, size_t ws_size, hipStream_t stream) {
    static int grid = 0;
    if (grid == 0) {
        if (n_in != 23 || out_size != MTOK * DM || ws_size < WS_END) { fprintf(stderr, "kernel_launch: unexpected problem: n_in %d out %d ws %zu\n", n_in, out_size, ws_size); grid = -1; return; }
        int dev = 0, cus = 0;
        if (hipGetDevice(&dev) != hipSuccess || hipDeviceGetAttribute(&cus, hipDeviceAttributeMultiprocessorCount, dev) != hipSuccess) { grid = -1; return; }
        if (hipFuncSetAttribute((const void*)mk_fwd, hipFuncAttributeMaxDynamicSharedMemorySize, LDS_BYTES) != hipSuccess) { fprintf(stderr, "kernel_launch: hipFuncSetAttribute failed\n"); grid = -1; return; }
        (void)hipGetLastError();
        grid = cus;
    }
    if (grid < 0) return;
    (void)hipMemsetAsync((char*)d_ws + WS_CTL, 0, CTL_ZERO_BYTES, stream);
    Args a{};
    for (int i = 0; i < 23; ++i) a.in[i] = (const float*)d_in[i];
    a.out = (float*)d_out; a.ws = (unsigned char*)d_ws;
    unsigned char* ws = (unsigned char*)d_ws;
    int nl = 0;
    auto run = [&](int lo, int hi) { a.ph_lo = lo; a.ph_hi = hi; a.li = nl++; hipLaunchKernelGGL(mk_fwd, dim3(grid), dim3(NWAVES * 64), LDS_BYTES, stream, a); };
    typedef unsigned short b16;
    run(0, 14);
}
```

```cpp
#include <hip/hip_runtime.h>
#include <hip/hip_bf16.h>
#include <cstdio>
#include <cstdint>
#include <cmath>
namespace pg8 {
#define PG8_LAS __attribute__((address_space(3)))
typedef unsigned short bf16_t;
typedef short bf16x8 __attribute__((ext_vector_type(8)));
typedef float f32x4 __attribute__((ext_vector_type(4)));
typedef unsigned u32x4 __attribute__((ext_vector_type(4)));
constexpr int BM = 256, BK = 64, HALF = 128, HTB = HALF * BK * 2  , STAGE_BYTES = 8 * HTB, NXCD = 8, WGM = 8;

__host__ __device__ __forceinline__ int lds_byte(int r, int c) { const int st = (r >> 4) * 2 + (c >> 5), rr = r & 15, cc = c & 31, ob = rr * 64 + cc * 2; return st * 1024 + (ob ^ (((ob >> 9) & 1) << 5)); }
__host__ __device__ __forceinline__ void stage_rc(int b, int& R, int& C) { const int st = b / 1024, sb = b % 1024, swz = sb ^ (((sb >> 9) & 1) << 5); R = (st >> 1) * 16 + swz / 64; C = (st & 1) * 32 + (swz % 64) / 2; }
__host__ __device__ __forceinline__ int perm32(int rho) { const int n = rho >> 4, i = rho & 15; return 8 * (i >> 2) + 4 * n + (i & 3); }

struct Unit { int pm, pn; };
struct Gemm { const bf16_t* A; const bf16_t* Bt; int M, N, K; };

struct StaticOrder {
    int nM, nN, nwg, G, c;
    __host__ __device__ void init(int M, int N, int G_, int c_) { nM = M / BM; nN = N / BM; nwg = nM * nN; G = G_; c = c_; }
    __host__ __device__ bool next(int i, Unit& u) const {
        const long L = (long)i * G + c; if (L >= nwg) return false;
        int wgid = (int)L; { const int q = nwg / NXCD, r = nwg % NXCD, xcd = wgid % NXCD, off = wgid / NXCD; wgid = (xcd < r ? xcd * (q + 1) : r * (q + 1) + (xcd - r) * q) + off; }
        const int nig = WGM * nN, gid = wgid / nig, fm = gid * WGM, gsz = (nM - fm) < WGM ? (nM - fm) : WGM;
        u.pm = fm + ((wgid % nig) % gsz); u.pn = (wgid % nig) / gsz; return true;
    }
    __device__ __forceinline__ void a_ready(const Unit&) const {}
    __device__ __forceinline__ void done(const Unit&) const {}
};

__device__ __forceinline__ unsigned cvt_pk_bf16(float lo, float hi) { unsigned r; asm volatile("v_cvt_pk_bf16_f32 %0, %1, %2" : "=v"(r) : "v"(lo), "v"(hi)); return r; }
typedef float f32x2 __attribute__((ext_vector_type(2)));
typedef unsigned u32x2 __attribute__((ext_vector_type(2)));
constexpr float RMS_EPS = 1e-6f;
__device__ __forceinline__ float row_rstd(const float* ssp, int nparts, int row) {
    const float* p = ssp + (size_t)row * 16; float s;
    if (nparts == 1) s = p[0];
    else { const f32x4 a = *(const f32x4*)p, b = *(const f32x4*)(p + 4), c = *(const f32x4*)(p + 8), d = *(const f32x4*)(p + 12);
        s = ((a[0] + a[1]) + (a[2] + a[3])) + ((b[0] + b[1]) + (b[2] + b[3])) + ((c[0] + c[1]) + (c[2] + c[3])) + ((d[0] + d[1]) + (d[2] + d[3])); }
    return 1.0f / sqrtf(s * (1.0f / 1024.0f) + RMS_EPS);
}
template <int ACT  , bool ROT, bool NRM = false>
struct EpiRsBf16 {
    static constexpr bool PERM = true, AFTER_DRAIN = false;
    bf16_t* O; int ldc; int tps; size_t split_stride; const float* ssp; int nparts; const float* rot; int rot_lo, rot_hi; unsigned* nrm;
    __device__ __forceinline__ void operator()(const f32x4 (&acc)[2][2][4][2], const Unit& u, int wr, int wc, int fr, int fq) const {
        const int row0 = u.pm * BM + wr * 64 + fr;
        int colt = u.pn * BM; bf16_t* base = O;
        if (tps) { const int t = u.pn / tps; base += (size_t)t * split_stride; colt = (u.pn - t * tps) * BM; }
        const int col0 = colt + wc * 32 + 8 * fq;
        const bool dorot = ROT && (u.pn >= rot_lo) && (u.pn < rot_hi);
        float nmax[2] = {0.f, 0.f};
#pragma unroll
        for (int ai = 0; ai < 2; ++ai)
#pragma unroll
            for (int m = 0; m < 4; ++m) {
                const int row = row0 + ai * HALF + m * 16;
                const float rs = row_rstd(ssp, nparts, row);
                bf16_t* rowp = base + (size_t)row * ldc + col0;
                f32x4 c01 = {1.f, 0.f, 1.f, 0.f}, c23 = {1.f, 0.f, 1.f, 0.f};
                if (ROT) { if (dorot) { const float* tp = rot + ((size_t)(row & 4095) * 64 + wc * 16 + 4 * fq) * 2; c01 = *(const f32x4*)tp; c23 = *(const f32x4*)(tp + 4); } }
#pragma unroll
                for (int bj = 0; bj < 2; ++bj) {
                    f32x4 v0 = acc[ai][bj][m][0] * rs, v1 = acc[ai][bj][m][1] * rs;
                    if (ACT == 1) {
#pragma unroll
                        for (int j = 0; j < 4; ++j) { const float a = v0[j] > 0.f ? v0[j] : 0.f, b = v1[j] > 0.f ? v1[j] : 0.f; v0[j] = a * a; v1[j] = b * b; }
                    }
                    if (ROT) {
                        const f32x4 a0 = v0, a1 = v1;
                        v0[0] = a0[0] * c01[0] - a0[1] * c01[1]; v0[1] = a0[0] * c01[1] + a0[1] * c01[0];
                        v0[2] = a0[2] * c01[2] - a0[3] * c01[3]; v0[3] = a0[2] * c01[3] + a0[3] * c01[2];
                        v1[0] = a1[0] * c23[0] - a1[1] * c23[1]; v1[1] = a1[0] * c23[1] + a1[1] * c23[0];
                        v1[2] = a1[2] * c23[2] - a1[3] * c23[3]; v1[3] = a1[2] * c23[3] + a1[3] * c23[2];
                    }
                    if (NRM) { float q2 = ((v0[0] * v0[0] + v0[1] * v0[1]) + (v0[2] * v0[2] + v0[3] * v0[3])) + ((v1[0] * v1[0] + v1[1] * v1[1]) + (v1[2] * v1[2] + v1[3] * v1[3]));
                        q2 += __shfl_xor(q2, 16); q2 += __shfl_xor(q2, 32); nmax[bj] = fmaxf(nmax[bj], q2); }
                    u32x4 w; w.x = cvt_pk_bf16(v0[0], v0[1]); w.y = cvt_pk_bf16(v0[2], v0[3]); w.z = cvt_pk_bf16(v1[0], v1[1]); w.w = cvt_pk_bf16(v1[2], v1[3]);
                    *(u32x4*)(rowp + bj * HALF) = w;
                }
            }
        if (NRM) { if (u.pn < 4) {
#pragma unroll
            for (int bj = 0; bj < 2; ++bj) { float q2 = nmax[bj];
#pragma unroll
                for (int o = 1; o < 16; o <<= 1) q2 = fmaxf(q2, __shfl_xor(q2, o));
                if (fr == 0 && fq == 0) { const int b = (u.pm * BM) >> 12, head = (u.pn & 1) * 4 + bj * 2 + (wc >> 1);
                    atomicMax(nrm + (b * 8 + head) * 4 + 2 * (u.pn >> 1) + (wc & 1), __float_as_uint(q2)); } } } }
    }
};
template <bool RES_BF16>
struct EpiResid {
    static constexpr bool PERM = false, AFTER_DRAIN = false;
    const float* resid_f; const bf16_t* resid_b; bf16_t* xb; float* ssp; int ldc;
    __device__ __forceinline__ void operator()(const f32x4 (&acc)[2][2][4][2], const Unit& u, int wr, int wc, int fr, int fq) const {
        const int col0 = u.pn * BM + wc * 32 + 4 * fq;
#pragma unroll
        for (int ai = 0; ai < 2; ++ai)
#pragma unroll
            for (int m = 0; m < 4; ++m) {
                const int row = u.pm * BM + ai * HALF + wr * 64 + m * 16 + fr; const size_t off = (size_t)row * ldc + col0; float ss = 0.f;
                f32x4 r[2][2];
#pragma unroll
                for (int bj = 0; bj < 2; ++bj)
#pragma unroll
                    for (int n = 0; n < 2; ++n) {
                        if (RES_BF16) { const u32x2 w = *(const u32x2*)(resid_b + off + bj * HALF + n * 16);
                            r[bj][n] = (f32x4){__uint_as_float(w.x << 16), __uint_as_float(w.x & 0xffff0000u), __uint_as_float(w.y << 16), __uint_as_float(w.y & 0xffff0000u)}; }
                        else r[bj][n] = *(const f32x4*)(resid_f + off + bj * HALF + n * 16);
                    }
#pragma unroll
                for (int bj = 0; bj < 2; ++bj)
#pragma unroll
                    for (int n = 0; n < 2; ++n) {
                        const f32x4 o = r[bj][n] + acc[ai][bj][m][n];
                        ss += (o[0] * o[0] + o[1] * o[1]) + (o[2] * o[2] + o[3] * o[3]);
                        u32x2 w; w.x = cvt_pk_bf16(o[0], o[1]); w.y = cvt_pk_bf16(o[2], o[3]); *(u32x2*)(xb + off + bj * HALF + n * 16) = w;
                    }
                ss += __shfl_xor(ss, 16); ss += __shfl_xor(ss, 32);
                if (fq == 0) ssp[(size_t)row * 16 + u.pn * 4 + wc] = ss;
                asm volatile("" ::: "memory");
            }
    }
};
struct EpiGlu {
    static constexpr bool PERM = true, AFTER_DRAIN = false;
    const bf16_t* Y; int ldy; const float* bias; bf16_t* O; int ldo; int ocol0;
    __device__ __forceinline__ void operator()(const f32x4 (&acc)[2][2][4][2], const Unit& u, int wr, int wc, int fr, int fq) const {
        const int row0 = u.pm * BM + wr * 64 + fr, col0 = u.pn * BM + wc * 32 + 8 * fq;
#pragma unroll
        for (int bj = 0; bj < 2; ++bj) {
            const f32x4 b0 = *(const f32x4*)(bias + col0 + bj * HALF), b1 = *(const f32x4*)(bias + col0 + bj * HALF + 4);
#pragma unroll
            for (int ai = 0; ai < 2; ++ai)
#pragma unroll
                for (int m = 0; m < 4; ++m) {
                    const int row = row0 + ai * HALF + m * 16;
                    const u32x4 yw = *(const u32x4*)(Y + (size_t)row * ldy + col0 + bj * HALF);
                    const f32x4 z0 = acc[ai][bj][m][0] + b0, z1 = acc[ai][bj][m][1] + b1;
                    float y[8], o[8];
                    y[0] = __uint_as_float(yw.x << 16); y[1] = __uint_as_float(yw.x & 0xffff0000u); y[2] = __uint_as_float(yw.y << 16); y[3] = __uint_as_float(yw.y & 0xffff0000u);
                    y[4] = __uint_as_float(yw.z << 16); y[5] = __uint_as_float(yw.z & 0xffff0000u); y[6] = __uint_as_float(yw.w << 16); y[7] = __uint_as_float(yw.w & 0xffff0000u);
#pragma unroll
                    for (int j = 0; j < 4; ++j) { o[j] = y[j] / (1.0f + __expf(-z0[j])); o[4 + j] = y[4 + j] / (1.0f + __expf(-z1[j])); }
                    u32x4 w; w.x = cvt_pk_bf16(o[0], o[1]); w.y = cvt_pk_bf16(o[2], o[3]); w.z = cvt_pk_bf16(o[4], o[5]); w.w = cvt_pk_bf16(o[6], o[7]);
                    *(u32x4*)(O + (size_t)row * ldo + ocol0 + col0 + bj * HALF) = w;
                }
        }
    }
};

template <class Epi, class Sched, bool ALIGN_EPI = false, bool SP2 = false>
__device__ __forceinline__ void gemm_phase(PG8_LAS unsigned char* lds, const Gemm g, const Sched& S, const Epi& E) {
    const int tid = threadIdx.x, wid = __builtin_amdgcn_readfirstlane(tid >> 6), lane = tid & 63, wr = wid >> 2, wc = wid & 3, fr = lane & 15, fq = lane >> 4;
    const int K = g.K, nt = K / BK;
    unsigned voffA[2], voffB[2];
#pragma unroll
    for (int i = 0; i < 2; ++i) { int R, C; stage_rc(tid * 16 + i * 8192, R, C); const int Rb = Epi::PERM ? ((R & ~31) + perm32(R & 31)) : R;
        voffA[i] = (unsigned)(R * K + C) * 2u; voffB[i] = (unsigned)(Rb * K + C) * 2u; }
    const size_t kstep = (size_t)(BK * 2);
    const size_t hstep = (size_t)HALF * K * 2;
    const size_t tstep = 2 * hstep;
    const unsigned ldsw = (unsigned)wid * 1024u;
    const int aoff = lds_byte(wr * 64 + fr, fq * 8), boff = lds_byte(wc * 32 + fr, fq * 8);
#define PG8_SA(b, h) (((b) * 2 + (h)) * HTB)
#define PG8_SB(b, h) ((4 + (b) * 2 + (h)) * HTB)
#define PG8_STAGE(bufoff, gbase, voff) do { _Pragma("unroll") for (int _i = 0; _i < 2; ++_i) \
        __builtin_amdgcn_global_load_lds((const unsigned*)((const char*)(gbase) + (voff)[_i]), (PG8_LAS unsigned*)(lds + (bufoff) + ldsw + _i * 8192), 16, 0, 0); } while (0)
#define PG8_LDA(dst, b, h) do { _Pragma("unroll") for (int m = 0; m < 4; ++m) _Pragma("unroll") for (int k = 0; k < 2; ++k) dst[m][k] = *(const PG8_LAS bf16x8*)(lds + PG8_SA(b, h) + aoff + m * 2048 + k * 1024); } while (0)
#define PG8_LDB(dst, b, h) do { _Pragma("unroll") for (int n = 0; n < 2; ++n) _Pragma("unroll") for (int k = 0; k < 2; ++k) dst[n][k] = *(const PG8_LAS bf16x8*)(lds + PG8_SB(b, h) + boff + n * 2048 + k * 1024); } while (0)
#define PG8_MMA(ai, bj, At, Bt) do { __builtin_amdgcn_s_setprio(1); _Pragma("unroll") for (int m = 0; m < 4; ++m) _Pragma("unroll") for (int n = 0; n < 2; ++n) _Pragma("unroll") for (int k = 0; k < 2; ++k) \
        acc[ai][bj][m][n] = __builtin_amdgcn_mfma_f32_16x16x32_bf16(Bt[n][k], At[m][k], acc[ai][bj][m][n], 0, 0, 0); __builtin_amdgcn_s_setprio(0); } while (0)
#define PG8_WAIT_V(n) asm volatile("s_waitcnt vmcnt(" #n ")" ::: "memory")
#define PG8_WAIT_L(n) asm volatile("s_waitcnt lgkmcnt(" #n ")" ::: "memory")
#define PG8_BAR __builtin_amdgcn_s_barrier()
#define PG8_SCHED __builtin_amdgcn_sched_barrier(0)
    Unit cur, nxt; int ui = 0;
    if (!S.next(0, cur)) return;
    f32x4 acc[2][2][4][2];
#pragma unroll
    for (int a = 0; a < 2; ++a)
#pragma unroll
        for (int b = 0; b < 2; ++b)
#pragma unroll
            for (int m = 0; m < 4; ++m)
#pragma unroll
                for (int n = 0; n < 2; ++n) acc[a][b][m][n] = (f32x4){0.f, 0.f, 0.f, 0.f};
    bf16x8 At[4][2], B0[2][2], B1[2][2];
    const char* cA = (const char*)g.A + (size_t)cur.pm * tstep; const char* cB = (const char*)g.Bt + (size_t)cur.pn * tstep;
    S.a_ready(cur);
    if constexpr (SP2) {
        PG8_STAGE(PG8_SB(0, 0), cB, voffB); PG8_STAGE(PG8_SB(0, 1), cB + hstep, voffB); PG8_STAGE(PG8_SA(0, 0), cA, voffA); PG8_STAGE(PG8_SA(0, 1), cA + hstep, voffA);
        if (wr == 1) PG8_BAR;
        PG8_WAIT_V(2); PG8_BAR;
        PG8_STAGE(PG8_SB(1, 0), cB + kstep, voffB); PG8_STAGE(PG8_SA(1, 0), cA + kstep, voffA); PG8_STAGE(PG8_SB(1, 1), cB + hstep + kstep, voffB);
        PG8_WAIT_V(6); PG8_BAR;
    } else {
        PG8_STAGE(PG8_SB(0, 0), cB, voffB); PG8_STAGE(PG8_SA(0, 0), cA, voffA); PG8_STAGE(PG8_SB(0, 1), cB + hstep, voffB); PG8_STAGE(PG8_SA(0, 1), cA + hstep, voffA);
        if (wr == 1) PG8_BAR;
        PG8_WAIT_V(4); PG8_BAR;
        PG8_STAGE(PG8_SB(1, 0), cB + kstep, voffB); PG8_STAGE(PG8_SA(1, 0), cA + kstep, voffA); PG8_STAGE(PG8_SB(1, 1), cB + hstep + kstep, voffB);
        PG8_WAIT_V(6); PG8_BAR;
    }
    for (;;) {
        const bool has_next = S.next(ui + 1, nxt);
        const char* nA = has_next ? (const char*)g.A + (size_t)nxt.pm * tstep : cA; const char* nB = has_next ? (const char*)g.Bt + (size_t)nxt.pn * tstep : cB;
        for (int t = 0; t < nt; t += 2) {
            const bool last = (t == nt - 2);
            const char* a1 = cA + (size_t)(t + 1) * kstep;
            const char* a2 = last ? nA : cA + (size_t)(t + 2) * kstep; const char* b2 = last ? nB : cB + (size_t)(t + 2) * kstep;
            const char* a3 = a2 + kstep; const char* b3 = b2 + kstep;
            if (last && has_next) S.a_ready(nxt);
            if constexpr (SP2) {
            PG8_LDB(B0, 0, 0); PG8_LDB(B1, 0, 1); PG8_SCHED; PG8_LDA(At, 0, 0); PG8_STAGE(PG8_SA(1, 1), a1 + hstep, voffA);
            PG8_WAIT_V(8); PG8_WAIT_L(0); PG8_BAR; PG8_MMA(0, 0, At, B0); PG8_MMA(0, 1, At, B1); PG8_BAR; PG8_SCHED;
            PG8_LDA(At, 0, 1); PG8_STAGE(PG8_SB(0, 0), b2, voffB); PG8_STAGE(PG8_SB(0, 1), b2 + hstep, voffB); PG8_STAGE(PG8_SA(0, 0), a2, voffA);
            PG8_WAIT_V(8); PG8_WAIT_L(0); PG8_BAR; PG8_MMA(1, 0, At, B0); PG8_MMA(1, 1, At, B1); PG8_BAR; PG8_SCHED;
            PG8_LDB(B0, 1, 0); PG8_LDB(B1, 1, 1); PG8_SCHED; PG8_LDA(At, 1, 0); PG8_STAGE(PG8_SA(0, 1), a2 + hstep, voffA);
            PG8_WAIT_V(8); PG8_WAIT_L(0); PG8_BAR; PG8_MMA(0, 0, At, B0); PG8_MMA(0, 1, At, B1); PG8_BAR; PG8_SCHED;
            PG8_LDA(At, 1, 1); PG8_STAGE(PG8_SB(1, 0), b3, voffB); PG8_STAGE(PG8_SB(1, 1), b3 + hstep, voffB); PG8_STAGE(PG8_SA(1, 0), a3, voffA);
            PG8_WAIT_V(8); PG8_WAIT_L(0); PG8_BAR; PG8_MMA(1, 0, At, B0); PG8_MMA(1, 1, At, B1); PG8_BAR; PG8_SCHED;
            } else {
            PG8_LDB(B0, 0, 0); PG8_SCHED; PG8_LDA(At, 0, 0); PG8_STAGE(PG8_SA(1, 1), a1 + hstep, voffA);
            PG8_WAIT_L(8); PG8_BAR; PG8_WAIT_L(0); PG8_MMA(0, 0, At, B0); PG8_BAR; PG8_SCHED;
            PG8_LDB(B1, 0, 1); PG8_STAGE(PG8_SB(0, 0), b2, voffB);
            PG8_BAR; PG8_WAIT_L(0); PG8_MMA(0, 1, At, B1); PG8_BAR;
            PG8_LDA(At, 0, 1); PG8_STAGE(PG8_SA(0, 0), a2, voffA);
            PG8_BAR; PG8_WAIT_L(0); PG8_MMA(1, 0, At, B0); PG8_BAR; PG8_SCHED;
            PG8_STAGE(PG8_SB(0, 1), b2 + hstep, voffB);
            PG8_WAIT_V(6); PG8_BAR; PG8_MMA(1, 1, At, B1); PG8_BAR;
            PG8_LDB(B0, 1, 0); PG8_SCHED; PG8_LDA(At, 1, 0); PG8_STAGE(PG8_SA(0, 1), a2 + hstep, voffA);
            PG8_WAIT_L(8); PG8_BAR; PG8_WAIT_L(0); PG8_MMA(0, 0, At, B0); PG8_BAR; PG8_SCHED;
            PG8_LDB(B1, 1, 1); PG8_STAGE(PG8_SB(1, 0), b3, voffB);
            PG8_BAR; PG8_WAIT_L(0); PG8_MMA(0, 1, At, B1); PG8_BAR;
            PG8_LDA(At, 1, 1); PG8_STAGE(PG8_SA(1, 0), a3, voffA);
            PG8_BAR; PG8_WAIT_L(0); PG8_MMA(1, 0, At, B0); PG8_BAR; PG8_SCHED;
            PG8_STAGE(PG8_SB(1, 1), b3 + hstep, voffB);
            PG8_WAIT_V(6); PG8_BAR; PG8_MMA(1, 1, At, B1); PG8_BAR;
            }
        }
        if constexpr (ALIGN_EPI) { if (wr == 0) PG8_BAR; }
        if constexpr (!Epi::AFTER_DRAIN) { E(acc, cur, wr, wc, fr, fq); S.done(cur); }
        if (!has_next) break;
#pragma unroll
        for (int a = 0; a < 2; ++a)
#pragma unroll
            for (int b = 0; b < 2; ++b)
#pragma unroll
                for (int m = 0; m < 4; ++m)
#pragma unroll
                    for (int n = 0; n < 2; ++n) acc[a][b][m][n] = (f32x4){0.f, 0.f, 0.f, 0.f};
        cur = nxt; cA = nA; cB = nB; ++ui;
        if constexpr (ALIGN_EPI) { if (wr == 1) PG8_BAR; }
    }
    PG8_WAIT_V(0);
    if constexpr (!ALIGN_EPI) { if (wr == 0) PG8_BAR; }
    PG8_BAR;
    if constexpr (Epi::AFTER_DRAIN) { E.fused(acc, cur, wr, wc, fr, fq, lds, wid, lane); S.done(cur); }
#undef PG8_SA
#undef PG8_SB
#undef PG8_STAGE
#undef PG8_LDA
#undef PG8_LDB
#undef PG8_MMA
#undef PG8_WAIT_V
#undef PG8_WAIT_L
#undef PG8_BAR
#undef PG8_SCHED
}
}
namespace attn_body {
using bf16=__hip_bfloat16;
using bf16x8=__attribute__((ext_vector_type(8)))short;
using s16x4=__attribute__((ext_vector_type(4)))short;
using f32x16=__attribute__((ext_vector_type(16)))float;
using u32x4=__attribute__((ext_vector_type(4)))unsigned;
constexpr int BATCH=8,NHEAD=8,SEQ=4096,D=64,DM=NHEAD*D,DMO=1024;
constexpr int NW=8,QBLK=32,QB=QBLK*NW,KVBLK=64,NQB=SEQ/QB;
constexpr int ATTN_PITCH=DM, ATTN_UNIT_ROWS=QB;
constexpr int LDS_CK_OFF=83968;
__device__ __forceinline__ int crow(int r,int hi){return (r&3)+8*(r>>2)+4*hi;}
#define SBAR() __builtin_amdgcn_sched_barrier(0)
__device__ __forceinline__ void cmask(f32x16&p0,f32x16&p1,int jb,int qrel,int hi){
  const float NEG=-INFINITY; int kb=64*jb+4*hi;
  #pragma unroll
  for(int r=0;r<16;++r){int kv=kb+(r&3)+8*(r>>2); if(kv>qrel)p0[r]=NEG; if(kv+32>qrel)p1[r]=NEG;}
}

constexpr int NSLOT=3, SLOTB=8192;
constexpr int LDS_K=0, LDS_V=NSLOT*SLOTB, LDS_WS=2*NSLOT*SLOTB, LDS_OST=LDS_WS+NW*64*4, LDS_BYTES=LDS_OST+NW*4096;
constexpr float C2=0.125f*1.4426950408889634f;
__device__ __forceinline__ void glds16(const void*gsrc,unsigned lds_dst){unsigned keep;
  asm volatile("s_mov_b32 %0, m0\n\ts_mov_b32 m0, %2\n\ts_nop 0\n\tglobal_load_lds_dwordx4 %1, off\n\ts_mov_b32 m0, %0":"=&s"(keep):"v"(gsrc),"s"(lds_dst):"memory");}
__device__ __forceinline__ float max3f(float a,float b,float c){float r;asm("v_max3_f32 %0, %1, %2, %3":"=v"(r):"v"(a),"v"(b),"v"(c));return r;}
__device__ __forceinline__ float max2f(float a,float b){float r;asm("v_max_f32_e32 %0, %1, %2":"=v"(r):"v"(a),"v"(b));return r;}
__device__ __forceinline__ float fadd_s(float a,float b){float r;asm("v_add_f32_e32 %0, %1, %2":"=v"(r):"v"(a),"v"(b));return r;}
__device__ __forceinline__ float fsub_s(float a,float b){float r;asm("v_sub_f32_e32 %0, %1, %2":"=v"(r):"v"(a),"v"(b));return r;}
typedef float f32x2_t __attribute__((ext_vector_type(2))); typedef __bf16 bf16x2_t __attribute__((ext_vector_type(2)));
__device__ __forceinline__ unsigned cvtpk_s(float lo,float hi){f32x2_t v={lo,hi};bf16x2_t b=__builtin_convertvector(v,bf16x2_t);return __builtin_bit_cast(unsigned,b);}
#define WAIT_BAR(N) asm volatile("s_waitcnt vmcnt(" #N ") lgkmcnt(0)\n\ts_barrier":::"memory")

__device__ __forceinline__ void qkt(f32x16&p0,f32x16&p1,const char*Kslot,const bf16x8*qr,const f32x16&ini0,const f32x16&ini1,int r32,int hi){
  const char*kb=Kslot+hi*1024+r32*16;
  #pragma unroll
  for(int d0=0;d0<4;++d0){
    const bf16x8 b0=*reinterpret_cast<const bf16x8*>(kb+d0*2048);
    const bf16x8 b1=*reinterpret_cast<const bf16x8*>(kb+d0*2048+512);
    if(d0==0){p0=__builtin_amdgcn_mfma_f32_32x32x16_bf16(b0,qr[0],ini0,0,0,0);p1=__builtin_amdgcn_mfma_f32_32x32x16_bf16(b1,qr[0],ini1,0,0,0);}
    else{p0=__builtin_amdgcn_mfma_f32_32x32x16_bf16(b0,qr[d0],p0,0,0,0);p1=__builtin_amdgcn_mfma_f32_32x32x16_bf16(b1,qr[d0],p1,0,0,0);}}
}
typedef __attribute__((address_space(3))) const char* lds_cptr;
typedef short v4i16_t __attribute__((ext_vector_type(4)));
__device__ __forceinline__ void kload8(bf16x8*kf,lds_cptr kp){
  kf[0]=*(const __attribute__((address_space(3))) bf16x8*)(kp);      kf[1]=*(const __attribute__((address_space(3))) bf16x8*)(kp+512);
  kf[2]=*(const __attribute__((address_space(3))) bf16x8*)(kp+2048); kf[3]=*(const __attribute__((address_space(3))) bf16x8*)(kp+2560);
  kf[4]=*(const __attribute__((address_space(3))) bf16x8*)(kp+4096); kf[5]=*(const __attribute__((address_space(3))) bf16x8*)(kp+4608);
  kf[6]=*(const __attribute__((address_space(3))) bf16x8*)(kp+6144); kf[7]=*(const __attribute__((address_space(3))) bf16x8*)(kp+6656);
}
__device__ __forceinline__ void kload2(bf16x8*kf,lds_cptr kp,int j){ kf[2*j]=*(const __attribute__((address_space(3))) bf16x8*)(kp+j*2048); kf[2*j+1]=*(const __attribute__((address_space(3))) bf16x8*)(kp+j*2048+512); }
__device__ __forceinline__ s16x4 vtr(lds_cptr p){ return __builtin_bit_cast(s16x4,__builtin_amdgcn_ds_read_tr16_b64_v4i16((__attribute__((address_space(3))) v4i16_t*)p)); }
__device__ __forceinline__ float rowmax(const f32x16&p0,const f32x16&p1){
  float a=max3f(p0[0],p0[1],p1[0]),b=max3f(p0[2],p0[3],p1[1]);a=max3f(a,p1[2],p1[3]);
  #pragma unroll
  for(int r=4;r<16;r+=4){a=max3f(a,p0[r],p0[r+1]);b=max3f(b,p0[r+2],p0[r+3]);a=max3f(a,p1[r],p1[r+1]);b=max3f(b,p1[r+2],p1[r+3]);}
  const float m=max2f(a,b);
  auto rr=__builtin_amdgcn_permlane32_swap(__float_as_uint(m),__float_as_uint(m),false,false);
  return max2f(__uint_as_float(rr[0]),__uint_as_float(rr[1]));
}
__device__ __forceinline__ void pv(f32x16*o,int vb,bf16x8 pa0,bf16x8 pa1,bf16x8 pa2,bf16x8 pa3){
  #pragma unroll
  for(int d0=0;d0<2;++d0){s16x4 lo[4],hi[4];
    #pragma unroll
    for(int ks=0;ks<4;++ks){
      asm volatile("ds_read_b64_tr_b16 %0,%1 offset:%c2":"=&v"(lo[ks]):"v"(vb),"i"(d0*4096+ks*1024):"memory");
      asm volatile("ds_read_b64_tr_b16 %0,%1 offset:%c2":"=&v"(hi[ks]):"v"(vb),"i"(d0*4096+ks*1024+512):"memory");}
    asm volatile("s_waitcnt lgkmcnt(0)":::"memory");SBAR();
    #define PK(k) (bf16x8){lo[k][0],lo[k][1],lo[k][2],lo[k][3],hi[k][0],hi[k][1],hi[k][2],hi[k][3]}
    o[d0]=__builtin_amdgcn_mfma_f32_32x32x16_bf16(pa0,PK(0),o[d0],0,0,0);
    o[d0]=__builtin_amdgcn_mfma_f32_32x32x16_bf16(pa1,PK(1),o[d0],0,0,0);
    o[d0]=__builtin_amdgcn_mfma_f32_32x32x16_bf16(pa2,PK(2),o[d0],0,0,0);
    o[d0]=__builtin_amdgcn_mfma_f32_32x32x16_bf16(pa3,PK(3),o[d0],0,0,0);
    #undef PK
  }
}

#ifndef ATTN_STORE16
#define ATTN_STORE16(p,v) (*(u32x4*)(p)=(v))
#endif
template<int THRL> __device__ __forceinline__ void attn_unit(int b,int h,int qb,const bf16*Q,const bf16*__restrict__ K,const bf16*__restrict__ V,bf16*O,const float*CB,const unsigned*NRM,char*shm){
  const int tid=threadIdx.x,lane=tid&63,r32=lane&31,hi=lane>>5; const int wid=__builtin_amdgcn_readfirstlane(tid>>6);
  const long rowbase=(long)b*SEQ; const int q0=qb*QB;
  typedef float f32x4_t __attribute__((ext_vector_type(4)));
  const float*cbh=CB+(long)(b*NHEAD+h)*SEQ;
  int T0;
  { const unsigned*np=NRM+(b*NHEAD+h)*4; const float qn=__uint_as_float(np[0])+__uint_as_float(np[1]), kn=__uint_as_float(np[2])+__uint_as_float(np[3]);
    const float qk2=2.04f*__builtin_sqrtf(qn*kn);
    const int ntile=(q0+QB)/KVBLK; const bool need=(lane<ntile)?(qk2+cbh[q0]-cbh[64*lane+63]>=-40.0f):false;
    const unsigned long long bm=__ballot(need); int tmin=(bm!=0ull)?(int)__builtin_ctzll(bm):ntile; tmin&=~1; if(tmin>ntile-4)tmin=ntile-4; T0=__builtin_amdgcn_readfirstlane(tmin); }
  { const int n4=(q0+QB-64*T0)/4; __attribute__((address_space(3))) f32x4_t*ckl=(__attribute__((address_space(3))) f32x4_t*)((lds_cptr)shm+LDS_CK_OFF);
    for(int i=tid;i<n4;i+=NW*64)ckl[i]=((const f32x4_t*)(cbh+64*T0))[i]; }
  const bf16*Qw=Q+(rowbase+q0+wid*QBLK)*DM+h*D;
  const bf16*Kh=K+(rowbase+64*T0)*DM+h*D,*Vh=V+(rowbase+64*T0)*DM+h*D;
  const unsigned lds0=(unsigned)(uintptr_t)shm;
  float*wsf=(float*)(shm+LDS_WS)+wid*64;
  const bf16*ksrc=Kh+(long)lane*DM+wid*8;
  const bf16*vsrc=Vh+(long)(16*(wid&3)+(lane>>2))*DM+(wid>>2)*32+(lane&3)*8;
  const unsigned kdst=lds0+LDS_K+wid*1024, vdst=lds0+LDS_V+wid*1024;
  #define DMA_K(t,slot) glds16(ksrc+(long)(t)*KVBLK*DM,(unsigned)__builtin_amdgcn_readfirstlane(kdst+(slot)))
  #define DMA_V(t,slot) glds16(vsrc+(long)(t)*KVBLK*DM,(unsigned)__builtin_amdgcn_readfirstlane(vdst+(slot)))
  const int vb0=(int)(lds0+LDS_V)+((lane>>4)&1)*32+(lane&3)*8+(4*hi+((lane&15)>>2))*64;
  const char*Kbase=shm+LDS_K; bf16x8 kf[8];
  const lds_cptr shm3=(lds_cptr)shm; const lds_cptr kp0=shm3+LDS_K+hi*1024+r32*16; const lds_cptr vp0=shm3+LDS_V+((lane>>4)&1)*32+(lane&3)*8+(4*hi+((lane&15)>>2))*64;
  const int NT=(q0+QB)/KVBLK-T0;
  DMA_K(0,0);DMA_V(0,0);DMA_K(1,SLOTB);
  bf16x8 qr[4];
  #pragma unroll
  for(int d0=0;d0<4;++d0)qr[d0]=*reinterpret_cast<const bf16x8*>(&Qw[(long)r32*DM+d0*16+hi*8]);
  float mhat,l_reg=0.f;f32x16 o[2];o[0]=f32x16{};o[1]=f32x16{};
  const float cq=cbh[q0+wid*QBLK+r32];
  {
    const bf16*Kw=Kh+(long)(q0-64*T0+wid*QBLK+r32)*DM; float sd=0.f;
    _Pragma("unroll") for(int d0=0;d0<4;++d0){ const bf16x8 kk=*reinterpret_cast<const bf16x8*>(&Kw[d0*16+hi*8]);
      _Pragma("unroll") for(int j=0;j<8;++j) sd+=__uint_as_float((unsigned)(unsigned short)qr[d0][j]<<16)*__uint_as_float((unsigned)(unsigned short)kk[j]<<16); }
    auto rs_=__builtin_amdgcn_permlane32_swap(__float_as_uint(sd),__float_as_uint(sd),false,false); mhat=__uint_as_float(rs_[0])+__uint_as_float(rs_[1]); }
  float cqm=cq-mhat;
  const __attribute__((address_space(3))) float*ckb=(const __attribute__((address_space(3))) float*)((lds_cptr)shm+LDS_CK_OFF)+4*hi;
  #define CINIT(C0,C1,t) do{ const __attribute__((address_space(3))) float*cp_=ckb+64*(t); \
    _Pragma("unroll") for(int g_=0;g_<4;++g_){ const f32x4_t a_=*(const __attribute__((address_space(3))) f32x4_t*)(cp_+8*g_), b_=*(const __attribute__((address_space(3))) f32x4_t*)(cp_+32+8*g_); \
      _Pragma("unroll") for(int j_=0;j_<4;++j_){ C0[4*g_+j_]=cqm-a_[j_]; C1[4*g_+j_]=cqm-b_[j_]; } } }while(0)
  const int qrel=wid*QBLK+r32;
  #define CMASK(P0,P1,t) do{int jb_=(t)-(NT-4); if(jb_>=0)cmask(P0,P1,jb_,qrel,hi);}while(0)
  bool resc=false;
  #define START(P0,P1) do{ const float rm=rowmax(P0,P1); resc=false; \
    { const float dl=max2f(rm,0.f); mhat=fadd_s(mhat,dl); \
      _Pragma("unroll") for(int r=0;r<16;++r){P0[r]=fsub_s(P0[r],dl);P1[r]=fsub_s(P1[r],dl);} \
      cqm=cq-mhat; } \
    _Pragma("unroll") for(int r=0;r<16;++r)P0[r]=__builtin_amdgcn_exp2f(P0[r]); }while(0)
  #define RESC() do{ if(resc){ asm volatile("s_waitcnt lgkmcnt(0)":::"memory"); \
      _Pragma("unroll") for(int d_=0;d_<2;++d_) _Pragma("unroll") for(int r=0;r<16;++r)o[d_][r]*=wsf[crow(r,hi)]; } }while(0)
  f32x16 pA0,pA1,pB0,pB1;
  int sl_prev=0,sl_cur=0,sl_next=SLOTB;
  #define ROT() do{sl_prev=sl_cur;sl_cur=sl_next;sl_next=(sl_next==(NSLOT-1)*SLOTB)?0:sl_next+SLOTB;}while(0)
  DMA_K(2,2*SLOTB);
  WAIT_BAR(3);
  { f32x16 i0_,i1_; CINIT(i0_,i1_,0); qkt(pA0,pA1,Kbase,qr,i0_,i1_,r32,hi); } asm volatile("s_nop 15\n\ts_nop 7":"+v"(pA0),"+v"(pA1));CMASK(pA0,pA1,0);
  START(pA0,pA1);
  _Pragma("unroll") for(int r=0;r<16;++r)pA1[r]=__builtin_amdgcn_exp2f(pA1[r]);
  WAIT_BAR(0);
  DMA_K(3,0);DMA_V(1,SLOTB);
  ROT();
  kload8(kf,kp0+sl_cur);
  WAIT_BAR(2);
  s16x4 vlo[8],vhi[8]; u32x4 pw0,pw1,pw2,pw3;
  #define PKW(P,B) cvtpk_s(P[B],P[B+1])
  #define PAF(k) __builtin_bit_cast(bf16x8,pw##k)
  #define VFR(i) (bf16x8){vlo[i][0],vlo[i][1],vlo[i][2],vlo[i][3],vhi[i][0],vhi[i][1],vhi[i][2],vhi[i][3]}
  #define PIN(x) asm volatile("":"+v"(x))
  #define MX3(a,b,c) __builtin_fmaxf(__builtin_fmaxf((a),(b)),(c))
  #define GAPA(MF,A0,A1,A2,A3,W0,W1,PW) do{ MF; sacc+=A0; sacc+=A1; sacc+=A2; sacc+=A3; PIN(sacc); W0; W1; PIN(PW); SBAR(); }while(0)
  #define EX(v) __builtin_amdgcn_exp2f(v)
  #define GAPB(MF,X,B) do{ MF; X[B]=EX(X[B]); X[B+1]=EX(X[B+1]); X[B+2]=EX(X[B+2]); X[B+3]=EX(X[B+3]); PIN(X); SBAR(); }while(0)
  #define VRD(i) do{ vlo[i]=vtr(vp_+(((i)>>2)*4096+((i)&3)*1024)); vhi[i]=vtr(vp_+(((i)>>2)*4096+((i)&3)*1024+512)); }while(0)
  #define KRD(G,j) do{ if(G){ kload2(kf,kp0+sl_next,j); SBAR(); } }while(0)
  #define STEP(C0,C1,P0,P1,t,GK,GV,GL) do{ SBAR(); CINIT(C0,C1,t); SBAR(); \
    const lds_cptr vp_=vp0+sl_prev; \
    VRD(0); SBAR(); float sacc=(P0[0]+P0[1]); \
    GAPA(C0=__builtin_amdgcn_mfma_f32_32x32x16_bf16(kf[0],qr[0],C0,0,0,0), P0[2],P0[3],P0[4],P0[5],     pw0[0]=PKW(P0,0), pw0[1]=PKW(P0,2), pw0); \
    VRD(4); SBAR(); GAPA(C1=__builtin_amdgcn_mfma_f32_32x32x16_bf16(kf[1],qr[0],C1,0,0,0), P0[6],P0[7],P0[8],P0[9],     pw0[2]=PKW(P0,4), pw0[3]=PKW(P0,6), pw0); \
    VRD(1); SBAR(); GAPA(C0=__builtin_amdgcn_mfma_f32_32x32x16_bf16(kf[2],qr[1],C0,0,0,0),   P0[10],P0[11],P0[12],P0[13], pw1[0]=PKW(P0,8), pw1[1]=PKW(P0,10), pw1); \
    VRD(5); SBAR(); GAPA(C1=__builtin_amdgcn_mfma_f32_32x32x16_bf16(kf[3],qr[1],C1,0,0,0),   P0[14],P0[15],P1[0],P1[1],   pw1[2]=PKW(P0,12),pw1[3]=PKW(P0,14), pw1); \
    VRD(2); SBAR(); GAPA(C0=__builtin_amdgcn_mfma_f32_32x32x16_bf16(kf[4],qr[2],C0,0,0,0),   P1[2],P1[3],P1[4],P1[5],     pw2[0]=PKW(P1,0), pw2[1]=PKW(P1,2), pw2); \
    VRD(6); SBAR(); GAPA(C1=__builtin_amdgcn_mfma_f32_32x32x16_bf16(kf[5],qr[2],C1,0,0,0),   P1[6],P1[7],P1[8],P1[9],     pw2[2]=PKW(P1,4), pw2[3]=PKW(P1,6), pw2); \
    VRD(3); SBAR(); GAPA(C0=__builtin_amdgcn_mfma_f32_32x32x16_bf16(kf[6],qr[3],C0,0,0,0),   P1[10],P1[11],P1[12],P1[13], pw3[0]=PKW(P1,8), pw3[1]=PKW(P1,10), pw3); \
    VRD(7); SBAR(); GAPA(C1=__builtin_amdgcn_mfma_f32_32x32x16_bf16(kf[7],qr[3],C1,0,0,0),   P1[14],P1[15],0.f,0.f,       pw3[2]=PKW(P1,12),pw3[3]=PKW(P1,14), pw3); \
    l_reg+=sacc; \
    if(GK){DMA_K((t)+3,sl_cur);} if(GV){DMA_V((t)+1,sl_next);} \
    CMASK(C0,C1,t); \
    { float a=MX3(C0[0],C0[1],C1[0]),b=MX3(C0[2],C0[3],C1[1]); a=MX3(a,C1[2],C1[3]); \
      _Pragma("unroll") for(int r=4;r<16;r+=4){a=MX3(a,C0[r],C0[r+1]);b=MX3(b,C0[r+2],C0[r+3]);a=MX3(a,C1[r],C1[r+1]);b=MX3(b,C1[r+2],C1[r+3]);} \
      float rm=__builtin_fmaxf(a,b); { auto rr=__builtin_amdgcn_permlane32_swap(__float_as_uint(rm),__float_as_uint(rm),false,false); rm=__builtin_fmaxf(__uint_as_float(rr[0]),__uint_as_float(rr[1])); } \
      resc=false; \
      if(__builtin_expect(__any(rm>(float)THRL),0)){ const float dl=__builtin_fmaxf(rm,0.f); mhat+=dl; \
        _Pragma("unroll") for(int r=0;r<16;++r){C0[r]-=dl;C1[r]-=dl;} \
        cqm=cq-mhat; \
        const float f=__builtin_amdgcn_exp2f(-dl); l_reg*=f; if(hi==0)wsf[r32]=f; resc=true; } } \
    SBAR(); \
    GAPB(o[0]=__builtin_amdgcn_mfma_f32_32x32x16_bf16(PAF(0),VFR(0),o[0],0,0,0), C0,0); \
    GAPB(o[1]=__builtin_amdgcn_mfma_f32_32x32x16_bf16(PAF(0),VFR(4),o[1],0,0,0), C0,4); \
    KRD(GL,0); GAPB(o[0]=__builtin_amdgcn_mfma_f32_32x32x16_bf16(PAF(1),VFR(1),o[0],0,0,0), C0,8); \
    KRD(GL,1); GAPB(o[1]=__builtin_amdgcn_mfma_f32_32x32x16_bf16(PAF(1),VFR(5),o[1],0,0,0), C0,12); \
    KRD(GL,2); GAPB(o[0]=__builtin_amdgcn_mfma_f32_32x32x16_bf16(PAF(2),VFR(2),o[0],0,0,0), C1,0); \
    KRD(GL,3); GAPB(o[1]=__builtin_amdgcn_mfma_f32_32x32x16_bf16(PAF(2),VFR(6),o[1],0,0,0), C1,4); \
    GAPB(o[0]=__builtin_amdgcn_mfma_f32_32x32x16_bf16(PAF(3),VFR(3),o[0],0,0,0), C1,8); \
    GAPB(o[1]=__builtin_amdgcn_mfma_f32_32x32x16_bf16(PAF(3),VFR(7),o[1],0,0,0), C1,12); \
    }while(0)
  int t=1;
  #undef CMASK
  #define CMASK(P0,P1,t) do{}while(0)
  for(;t+5<NT;t+=2){
    STEP(pB0,pB1,pA0,pA1,t,true,true,true);     WAIT_BAR(2); RESC(); ROT();
    STEP(pA0,pA1,pB0,pB1,t+1,true,true,true);   WAIT_BAR(2); RESC(); ROT();
  }
  #undef CMASK
  #define CMASK(P0,P1,t) do{int jb_=(t)-(NT-4); if(jb_>=0)cmask(P0,P1,jb_,qrel,hi);}while(0)
  #define ENDW(tt) do{ if((tt)+3<NT){WAIT_BAR(2);} else if((tt)+2<NT){WAIT_BAR(1);} else {WAIT_BAR(0);} }while(0)
  for(;t+1<NT;t+=2){
    STEP(pB0,pB1,pA0,pA1,t,(t+3<NT),(t+1<NT),(t+1<NT));       ENDW(t);   RESC(); ROT();
    STEP(pA0,pA1,pB0,pB1,t+1,(t+4<NT),(t+2<NT),(t+2<NT));     ENDW(t+1); RESC(); ROT();
  }
  STEP(pB0,pB1,pA0,pA1,NT-1,false,false,false); RESC();
  { float sacc=pB0[0]+pB0[1]; _Pragma("unroll") for(int r=2;r<16;++r)sacc+=pB0[r]; _Pragma("unroll") for(int r=0;r<16;++r)sacc+=pB1[r]; l_reg+=sacc;
    pw0=(u32x4){PKW(pB0,0),PKW(pB0,2),PKW(pB0,4),PKW(pB0,6)};pw1=(u32x4){PKW(pB0,8),PKW(pB0,10),PKW(pB0,12),PKW(pB0,14)};pw2=(u32x4){PKW(pB1,0),PKW(pB1,2),PKW(pB1,4),PKW(pB1,6)};pw3=(u32x4){PKW(pB1,8),PKW(pB1,10),PKW(pB1,12),PKW(pB1,14)};
    SBAR(); pv(o,vb0+sl_cur,PAF(0),PAF(1),PAF(2),PAF(3)); }
  #undef PKW
  #undef PAF
  #undef VFR
  #undef PIN
  #undef MX3
  #undef GAPA
  #undef GAPB
  #undef EX
  #undef VRD
  #undef KRD
  #undef STEP
  #undef ENDW
  {auto rr=__builtin_amdgcn_permlane32_swap(__float_as_uint(l_reg),__float_as_uint(l_reg),false,false);l_reg=__uint_as_float(rr[0])+__uint_as_float(rr[1]);}
  if(hi==0)wsf[32+r32]=l_reg;asm volatile("s_waitcnt lgkmcnt(0)":::"memory");
  float rli[16];
  #pragma unroll
  for(int r=0;r<16;++r)rli[r]=__builtin_amdgcn_rcpf(wsf[32+crow(r,hi)]);
  bf16*Ow=O+(rowbase+q0+wid*QBLK)*DMO+h*D;
  { bf16*stg=(bf16*)(shm+LDS_OST)+wid*2048;
    #pragma unroll
    for(int r=0;r<16;++r){const int orow=crow(r,hi);
      #pragma unroll
      for(int d0=0;d0<2;++d0)stg[orow*64+d0*32+r32]=__float2bfloat16(o[d0][r]*rli[r]);}
    asm volatile("s_waitcnt lgkmcnt(0)":::"memory");
    #pragma unroll
    for(int i=0;i<4;++i){const int row=i*8+(lane>>3),ch=lane&7; const u32x4 v=*(const u32x4*)(stg+row*64+ch*8); ATTN_STORE16(Ow+(long)row*DMO+ch*8,v);} }
  asm volatile("s_waitcnt lgkmcnt(0)\n\ts_barrier":::"memory");
  #undef CINIT
  #undef DMA_K
  #undef DMA_V
  #undef CMASK
  #undef START
  #undef RESC
  #undef ROT
}
constexpr int ATTN_LDS_BYTES=LDS_BYTES;
struct AttnTensors { const bf16* Q; const bf16* K; const bf16* V; bf16* O; const float* CB; const unsigned* NRM; };
struct AttnUnit { int bh; int qb; };
struct StaticOrder {
  int vcu;
  __device__ __forceinline__ explicit StaticOrder(int grid,int block):vcu((block%8)*(grid/8)+block/8){}
  __device__ __forceinline__ bool next(int i,AttnUnit&u)const{ if(i>=4||vcu>=64*4)return false; const int s=vcu&3; u.bh=vcu>>2; u.qb=(i==0)?s:(i==1)?7-s:(i==2)?8+s:15-s; return true; }
  __device__ __forceinline__ void a_ready(const AttnUnit&)const{}
  __device__ __forceinline__ void done(const AttnUnit&)const{}
};
template<class Sched,int THRL=8> __device__ __forceinline__ void attn_phase(char*lds,const AttnTensors&T,const Sched&S){
  AttnUnit u;
  for(int i=0;S.next(i,u);++i){ S.a_ready(u); attn_unit<THRL>(u.bh/NHEAD,u.bh%NHEAD,u.qb,T.Q,T.K,T.V,T.O,T.CB,T.NRM,lds); S.done(u); }
}
#undef SBAR
#undef WAIT_BAR
}
#define GAS __attribute__((address_space(1)))
#define LAS __attribute__((address_space(3)))
typedef unsigned short bf16;
typedef unsigned v4u __attribute__((ext_vector_type(4)));
typedef float f32x4 __attribute__((ext_vector_type(4)));
typedef short bf16x8 __attribute__((ext_vector_type(8)));
typedef GAS unsigned gu32;
typedef GAS unsigned long long gu64;
#define RLX_AGENT __ATOMIC_RELAXED, __HIP_MEMORY_SCOPE_AGENT
#define LDS_WAIT() asm volatile("s_waitcnt lgkmcnt(0)" ::: "memory")
#define VM_WAIT() asm volatile("s_waitcnt vmcnt(0)" ::: "memory")
__device__ __forceinline__ unsigned long long rt() { return __builtin_amdgcn_s_memrealtime(); }
__device__ __forceinline__ unsigned f2bf(float f) { unsigned u = __builtin_bit_cast(unsigned, f); return (u + 0x7fffu + ((u >> 16) & 1u)) >> 16; }
__device__ __forceinline__ unsigned pk2(float lo, float hi) { return f2bf(lo) | (f2bf(hi) << 16); }

#define XB_TMO      128
#define XB_XCNT(j)  (256  + 64 * (j))
#define XB_XSUB(j)  (1280 + 64 * (j))
#define XB_XGEN(j)  (2304 + 64 * (j))
#define XB_TOP      3328
#define XB_TOPGEN   3392
#define XCD_BAR_WORDS 3456
#define XB_SPIN_CAP (1u << 18)

__device__ __forceinline__ unsigned xb_ld(unsigned* p)              { return __hip_atomic_load(p, __ATOMIC_RELAXED, __HIP_MEMORY_SCOPE_AGENT); }
__device__ __forceinline__ unsigned xb_add(unsigned* p, unsigned v) { return __hip_atomic_fetch_add(p, v, __ATOMIC_RELAXED, __HIP_MEMORY_SCOPE_AGENT); }
__device__ __forceinline__ unsigned xb_xcc_id() { return (unsigned)__builtin_amdgcn_s_getreg((3 << 11) | 20) & 0xFu; }
#define XB_SPIN(cond, bar) do { unsigned _sp = 0; while (cond) { __builtin_amdgcn_s_sleep(1); \
    if ((++_sp & 255u) == 0u) { if (xb_ld(&(bar)[XB_TMO])) break; if (_sp > XB_SPIN_CAP) { atomicAdd(&(bar)[XB_TMO], 1u); break; } } } } while (0)

struct XcdBarrier {
    unsigned* bar; unsigned x;
    volatile LAS unsigned* st;
};

__device__ __forceinline__ XcdBarrier xcd_barrier_post(unsigned* bar, volatile LAS unsigned* st) {
    XcdBarrier b; b.bar = bar; b.x = xb_xcc_id(); b.st = st;
    if (threadIdx.x == 0) (void)xb_add(&bar[XB_XCNT(b.x)], 1u);
    return b;
}
__device__ __forceinline__ void xcd_barrier_complete(unsigned* bar, unsigned x, unsigned& nloc, unsigned& nx) {
    const unsigned G = gridDim.x * gridDim.y * gridDim.z;
    unsigned sum, cnt, mine, sp = 0u;
    for (;;) {
        sum = 0u; cnt = 0u; mine = 0u;
#pragma unroll
        for (unsigned j = 0; j < 16; ++j) { const unsigned c = xb_ld(&bar[XB_XCNT(j)]); sum += c; cnt += (c > 0u) ? 1u : 0u; mine = (j == x) ? c : mine; }
        if (sum == G) break;
        __builtin_amdgcn_s_sleep(1);
        if ((++sp & 255u) == 0u) { if (xb_ld(&bar[XB_TMO])) break; if (sp > XB_SPIN_CAP) { atomicAdd(&bar[XB_TMO], 1u); break; } }
    }
    nloc = mine > 0u ? mine : 1u; nx = cnt > 0u ? cnt : 1u;
}

__device__ __forceinline__ void xcd_barrier(const XcdBarrier& b) {
    asm volatile("s_waitcnt vmcnt(0)" ::: "memory");
    __syncthreads();
    if (threadIdx.x == 0) {
        unsigned* bar = b.bar;
        __builtin_amdgcn_s_waitcnt(0);
        unsigned nloc = b.st[0], nx = b.st[1];
        if (nloc == 0u) { xcd_barrier_complete(bar, b.x, nloc, nx); b.st[0] = nloc; b.st[1] = nx; }
        const unsigned old = xb_add(&bar[XB_XSUB(b.x)], 1u);
        const unsigned gen = old / nloc;
        if (old + 1u == (gen + 1u) * nloc) {
            __builtin_amdgcn_fence(__ATOMIC_RELEASE, "agent");
            asm volatile("s_waitcnt vmcnt(0)" ::: "memory");
            const unsigned og = xb_add(&bar[XB_TOP], 1u);
            const unsigned tg = og / nx;
            if (og + 1u == (tg + 1u) * nx) xb_add(&bar[XB_TOPGEN], 1u);
            else XB_SPIN(xb_ld(&bar[XB_TOPGEN]) == tg, bar);
            __builtin_amdgcn_fence(__ATOMIC_ACQUIRE, "agent");
            xb_add(&bar[XB_XGEN(b.x)], 1u);
            asm volatile("s_waitcnt vmcnt(0)" ::: "memory");
        } else {
            XB_SPIN(xb_ld(&bar[XB_XGEN(b.x)]) == gen, bar);
            __builtin_amdgcn_fence(__ATOMIC_ACQUIRE, "agent");
            asm volatile("s_waitcnt vmcnt(0)" ::: "memory");
        }
    }
    __syncthreads();
}

constexpr int NWAVES = 8;
constexpr int NB = 8, SEQ = 4096, DM = 1024, MTOK = NB * SEQ, DFF = 4096;
constexpr float LOG2E = 1.4426950408889634f;
constexpr size_t MiB = 1u << 20;
constexpr size_t WS_CTL = 0, CTL_ZERO_BYTES = 1 * MiB;
constexpr size_t WS_WIN0 = 1 * MiB, WS_WGLU = 5 * MiB, WS_WOUT0 = 6 * MiB, WS_WUP0 = 8 * MiB, WS_WDN0 = 16 * MiB, WS_WIN1 = 24 * MiB, WS_WOUT1 = 31 * MiB, WS_WUP1 = 33 * MiB, WS_WDN1 = 41 * MiB;
constexpr size_t WS_SSP = 49 * MiB;
constexpr size_t WS_LOGF = 51 * MiB;
constexpr size_t WS_CB = 52 * MiB;
constexpr size_t WS_ROT = 53 * MiB;
constexpr size_t WS_XB = 64 * MiB;
constexpr size_t WS_BIG = 128 * MiB;
constexpr size_t WS_Q = 128 * MiB, WS_K = 160 * MiB, WS_V = 192 * MiB, WS_U = 224 * MiB, WS_YG = 256 * MiB, WS_MIX = 288 * MiB;
constexpr size_t WS_P1 = 128 * MiB;
constexpr size_t WS_MIX1 = 352 * MiB;
constexpr size_t WS_KV = 416 * MiB;
constexpr size_t WS_S4A = 480 * MiB;
constexpr size_t WS_END = 496 * MiB;
constexpr size_t P1_STRIDE = 32 * MiB / 2;
constexpr int CW_TMO = 0, CW_CODE = 1, CW_BAR = 4096;
constexpr int CW_NRM = 65536;
constexpr int RING_OFF = 0, RING_BYTES = 131072;
constexpr int LDSCTL_OFF = RING_BYTES, MISC_OFF = LDSCTL_OFF + 320;
constexpr int LDS_BYTES = 147456;


struct Frame {
    LAS unsigned char* lds;
    volatile LAS unsigned* MISC;
    gu32* ctl;
    int tid, lane, wave;
    int vcu, G;
};
struct Args { const float* in[23]; float* out; unsigned char* ws; int ph_lo, ph_hi, li, pad; };

__device__ __forceinline__ float wave_sum(float v) {
#pragma unroll
    for (int o = 1; o < 64; o <<= 1) v += __shfl_xor(v, o);
    return v;
}
__device__ __forceinline__ float bf2f(unsigned short u) { return __uint_as_float((unsigned)u << 16); }

__device__ __forceinline__ void p0_transpose_item(const float* W, int ldw, int scol, int K, int ncols, bf16* WT, int drow, const float* gain, float scale, LAS float* scr, int item, int lane) {
    const int nblk = ncols / 32, kb = item / nblk, nb = item % nblk, k0 = 64 * kb, n0 = 32 * nb;
#pragma unroll 8
    for (int i = 0; i < 32; ++i) { const int kk = 2 * i + (lane >> 5); float v = W[(size_t)(k0 + kk) * ldw + scol + n0 + (lane & 31)]; if (gain) v *= gain[k0 + kk]; scr[kk * 33 + (lane & 31)] = v * scale; }
    LDS_WAIT(); asm volatile("" ::: "memory");
    const int c = lane & 7;
#pragma unroll
    for (int j = 0; j < 4; ++j) { const int n = (lane >> 3) + 8 * j; const LAS float* s = scr + (8 * c) * 33 + n;
        v4u o; o.x = pk2(s[0 * 33], s[1 * 33]); o.y = pk2(s[2 * 33], s[3 * 33]); o.z = pk2(s[4 * 33], s[5 * 33]); o.w = pk2(s[6 * 33], s[7 * 33]);
        *(GAS v4u*)(WT + (size_t)(drow + n0 + n) * K + k0 + 8 * c) = o; }
    LDS_WAIT(); asm volatile("" ::: "memory");
}
__device__ __forceinline__ void rot_entry(int pos, int f, float& co, float& si) {
    const double inv = exp2(-(double)f * (13.287712379549449 / 63.0));
    const double ang = (double)pos * inv;
    const double twopi = 6.283185307179586476925, hp = 1.5707963267948966192;
    const double r = ang - twopi * rint(ang / twopi);
    const double kq = rint(r / hp), t = r - kq * hp, t2 = t * t;
    double sp = 1.0 / 6227020800.0; sp = sp * t2 - 1.0 / 39916800.0; sp = sp * t2 + 1.0 / 362880.0; sp = sp * t2 - 1.0 / 5040.0; sp = sp * t2 + 1.0 / 120.0; sp = sp * t2 - 1.0 / 6.0; sp = sp * t2 + 1.0; sp *= t;
    double cp = -1.0 / 87178291200.0; cp = cp * t2 + 1.0 / 479001600.0; cp = cp * t2 - 1.0 / 3628800.0; cp = cp * t2 + 1.0 / 40320.0; cp = cp * t2 - 1.0 / 720.0; cp = cp * t2 + 1.0 / 24.0; cp = cp * t2 - 0.5; cp = cp * t2 + 1.0;
    const int qd = ((int)kq) & 3; double s, c;
    if (qd == 0) { s = sp; c = cp; } else if (qd == 1) { s = cp; c = -sp; } else if (qd == 2) { s = -sp; c = -cp; } else { s = -cp; c = sp; }
    co = (float)c; si = (float)s;
}
__device__ __forceinline__ void p0_prologue(Frame& F, const Args& A) {
    unsigned char* ws = A.ws;
    const float* x = A.in[0]; const float* even_norm = A.in[1]; const float* even_w_in = A.in[2]; const float* even_bf = A.in[3];
    const float* w_glu = A.in[12]; const float* even_w_out = A.in[14]; const float* odd_norm = A.in[15]; const float* odd_w_in = A.in[16]; const float* odd_w_out = A.in[18];
    const float* mlp_norm = A.in[19]; const float* w_up = A.in[20]; const float* w_dn = A.in[21];
    LAS float* scr = (LAS float*)(F.lds + RING_OFF + F.wave * 9216);
    LAS float* GWs = (LAS float*)(F.lds + RING_OFF + 98304);
    const int gw = F.vcu * NWAVES + F.wave, NGW = F.G * NWAVES;
    for (int i = F.tid; i < 8192; i += NWAVES * 64) { const int h = i >> 10, k = i & 1023; GWs[i] = even_norm[k] * even_w_in[(size_t)k * 2056 + 1536 + h]; }
    constexpr int NITEMS = 12160;
    const float C2 = 0.125f * LOG2E, KS = 0.08838834764831845f;
    for (int it = gw; it < NITEMS; it += NGW) {
        int r = it;
#define SEG(cnt, W, ldw, scol, K, ncols, WT, drow, gain, scale) if (r < (cnt)) { p0_transpose_item(W, ldw, scol, K, ncols, (bf16*)(ws + (WT)), drow, gain, scale, scr, r, F.lane); continue; } r -= (cnt);
        SEG(256, even_w_in, 2056, 0, 1024, 512, WS_WIN0, 0, even_norm, C2)
        SEG(512, even_w_in, 2056, 512, 1024, 1024, WS_WIN0, 512, even_norm, 1.0f)
        SEG(256, even_w_in, 2056, 1544, 1024, 512, WS_WIN0, 1536, even_norm, 1.0f)
        SEG(128, w_glu, 512, 0, 512, 512, WS_WGLU, 0, nullptr, 1.0f)
        SEG(512, even_w_out, 1024, 0, 1024, 1024, WS_WOUT0, 0, nullptr, 1.0f)
        SEG(2048, w_up, 4096, 0, 1024, 4096, WS_WUP0, 0, mlp_norm, 1.0f)
        SEG(2048, w_dn, 1024, 0, 4096, 1024, WS_WDN0, 0, nullptr, 1.0f)
        SEG(1024, odd_w_in, 3584, 0, 1024, 2048, WS_WIN1, 0, odd_norm, 1.0f)
        SEG(256, odd_w_in, 3584, 2048, 1024, 512, WS_WIN1, 2048, odd_norm, KS)
        SEG(512, odd_w_in, 3584, 2560, 1024, 1024, WS_WIN1, 2560, odd_norm, 1.0f)
        SEG(512, odd_w_out, 1024, 0, 1024, 1024, WS_WOUT1, 0, nullptr, 1.0f)
        SEG(2048, w_up + (size_t)1024 * 4096, 4096, 0, 1024, 4096, WS_WUP1, 0, mlp_norm + 1024, 1.0f)
        SEG(2048, w_dn + (size_t)4096 * 1024, 1024, 0, 4096, 1024, WS_WDN1, 0, nullptr, 1.0f)
#undef SEG
    }
    { float* rot = (float*)(ws + WS_ROT);
      for (int i = F.vcu * (NWAVES * 64) + F.tid; i < SEQ * 64; i += F.G * NWAVES * 64) { float c, s; rot_entry(i >> 6, i & 63, c, s); *(float2*)(rot + 2 * (size_t)i) = make_float2(c, s); } }
    LDS_WAIT(); __syncthreads();
    bf16* XB = (bf16*)(ws + WS_XB); float* SSP = (float*)(ws + WS_SSP); float* LOGF = (float*)(ws + WS_LOGF);
    for (int m = gw; m < MTOK; m += NGW) {
        const GAS f32x4* xr = (const GAS f32x4*)(x + (size_t)m * DM) + F.lane;
        f32x4 v[4]; float ss = 0.f;
#pragma unroll
        for (int j = 0; j < 4; ++j) { v[j] = xr[64 * j]; ss += (v[j].x * v[j].x + v[j].y * v[j].y) + (v[j].z * v[j].z + v[j].w * v[j].w); }
        GAS unsigned long long* o8 = (GAS unsigned long long*)(XB + (size_t)m * DM) + F.lane;
#pragma unroll
        for (int j = 0; j < 4; ++j) o8[64 * j] = (unsigned long long)pk2(v[j].x, v[j].y) | ((unsigned long long)pk2(v[j].z, v[j].w) << 32);
        float fa[8];
#pragma unroll
        for (int h = 0; h < 8; ++h) { float a = 0.f;
#pragma unroll
            for (int j = 0; j < 4; ++j) { const f32x4 g4 = *(const LAS f32x4*)(GWs + h * 1024 + 256 * j + 4 * F.lane); a += (v[j].x * g4.x + v[j].y * g4.y) + (v[j].z * g4.z + v[j].w * g4.w); }
            fa[h] = wave_sum(a); }
        ss = wave_sum(ss);
        const float rstd = 1.0f / sqrtf(ss * (1.0f / DM) + 1e-6f);
        float z = 0.f;
#pragma unroll
        for (int h = 0; h < 8; ++h) if (F.lane == h) z = fa[h];
        if (F.lane < 8) { z = z * rstd + even_bf[F.lane];
            const float r = (z > 0.f) ? -log1pf(expf(-z)) : (z - log1pf(expf(z)));
            LOGF[((size_t)((m >> 12) * 8 + F.lane)) * SEQ + (m & 4095)] = r; }
        if (F.lane == 0) SSP[(size_t)m * 16] = ss;
    }
}
__device__ __forceinline__ void p1_cumsum(Frame& F, const Args& A, int bh) {
    const float* src = (const float*)(A.ws + WS_LOGF) + (size_t)bh * SEQ + F.tid * 8;
    float* dst = (float*)(A.ws + WS_CB) + (size_t)bh * SEQ + F.tid * 8;
    LAS float* wsum = (LAS float*)(F.lds + RING_OFF);
    const f32x4 a = *(const f32x4*)src, b = *(const f32x4*)(src + 4);
    float v[8] = {a.x, a.y, a.z, a.w, b.x, b.y, b.z, b.w};
#pragma unroll
    for (int i = 1; i < 8; ++i) v[i] += v[i - 1];
    const float tot = v[7]; float inc = tot;
#pragma unroll
    for (int o = 1; o < 64; o <<= 1) { const float t = __shfl_up(inc, o); if (F.lane >= o) inc += t; }
    if (F.lane == 63) wsum[F.wave] = inc;
    LDS_WAIT(); __syncthreads();
    float base = inc - tot;
#pragma unroll
    for (int w = 0; w < NWAVES; ++w) if (w < F.wave) base += wsum[w];
    f32x4 o0, o1;
    o0.x = (v[0] + base) * LOG2E; o0.y = (v[1] + base) * LOG2E; o0.z = (v[2] + base) * LOG2E; o0.w = (v[3] + base) * LOG2E;
    o1.x = (v[4] + base) * LOG2E; o1.y = (v[5] + base) * LOG2E; o1.z = (v[6] + base) * LOG2E; o1.w = (v[7] + base) * LOG2E;
    *(f32x4*)dst = o0; *(f32x4*)(dst + 4) = o1;
    LDS_WAIT(); __syncthreads();
}
__device__ __forceinline__ void p_final(Frame& F, const Args& A) {
    const int gw = F.vcu * NWAVES + F.wave, NGW = F.G * NWAVES;
    const float* g = A.in[22]; const bf16* XB = (const bf16*)(A.ws + WS_XB);
    f32x4 gg[4];
#pragma unroll
    for (int j = 0; j < 4; ++j) gg[j] = ((const f32x4*)g)[F.lane + 64 * j];
    for (int m = gw; m < MTOK; m += NGW) {
        const GAS unsigned long long* xr = (const GAS unsigned long long*)(XB + (size_t)m * DM) + F.lane;
        f32x4 v[4]; float ss = 0.f;
#pragma unroll
        for (int j = 0; j < 4; ++j) { const unsigned long long w = xr[64 * j]; const unsigned lo = (unsigned)w, hi = (unsigned)(w >> 32);
            v[j] = (f32x4){__uint_as_float(lo << 16), __uint_as_float(lo & 0xffff0000u), __uint_as_float(hi << 16), __uint_as_float(hi & 0xffff0000u)};
            ss += (v[j].x * v[j].x + v[j].y * v[j].y) + (v[j].z * v[j].z + v[j].w * v[j].w); }
        ss = wave_sum(ss);
        const float r = 1.0f / sqrtf(ss * (1.0f / DM) + 1e-6f);
        GAS f32x4* o = (GAS f32x4*)(A.out + (size_t)m * DM) + F.lane;
#pragma unroll
        for (int j = 0; j < 4; ++j) o[64 * j] = v[j] * r * gg[j];
    }
}

__device__ __forceinline__ float gelu_tanh_fast(float x) { const float u = 0.7978845608028654f * (x + 0.044715f * x * x * x); return x / (1.0f + __expf(-2.0f * u)); }
__device__ __forceinline__ void s5_lambar(float lr, float li, float dt, float& lbr, float& lbi) { const float er = expf(lr * dt); float sn, cs; sincosf(li * dt, &sn, &cs); lbr = er * cs; lbi = er * sn; }
template <bool PASS2>
__device__ __forceinline__ void s5_pass(const unsigned short* U, unsigned short* YG, size_t row0, int g, LAS float* BUs, LAS unsigned* Xs, const pg8::bf16x8 (&Bf)[8], const pg8::bf16x8 (&Cf)[4], const pg8::bf16x8& Df,
                                        float lbr, float lbi, float& xr, float& xi, int lane) {
    typedef float f32x2 __attribute__((ext_vector_type(2)));
    const int c16 = lane & 15, kq = lane >> 4;
    const pg8::bf16x8 zero8 = {0, 0, 0, 0, 0, 0, 0, 0};
    pg8::bf16x8 an = zero8;
    if (kq < 2) an = *(const pg8::bf16x8*)(U + (row0 + c16) * 512 + g * 16 + 8 * kq);
    for (int sc = 0; sc < 32; ++sc) {
        const size_t r0 = row0 + 16 * sc;
        const pg8::bf16x8 a = an;
        if (sc + 1 < 32) { if (kq < 2) an = *(const pg8::bf16x8*)(U + (r0 + 16 + c16) * 512 + g * 16 + 8 * kq); }
        unsigned short uw[4];
        if (PASS2) {
#pragma unroll
            for (int r = 0; r < 4; ++r) uw[r] = U[(r0 + 4 * kq + r) * 512 + g * 16 + c16]; }
#pragma unroll
        for (int nb = 0; nb < 8; ++nb) {
            pg8::f32x4 d = {0.f, 0.f, 0.f, 0.f};
            d = __builtin_amdgcn_mfma_f32_16x16x32_bf16(a, Bf[nb], d, 0, 0, 0);
#pragma unroll
            for (int r = 0; r < 4; ++r) BUs[(4 * kq + r) * 128 + 16 * nb + c16] = d[r];
        }
        f32x2 bu[16];
#pragma unroll
        for (int t = 0; t < 16; ++t) bu[t] = *(const LAS f32x2*)(BUs + t * 128 + 2 * lane);
        asm volatile("s_waitcnt lgkmcnt(0)" ::: "memory");
#pragma unroll
        for (int t = 0; t < 16; ++t) {
            const float nxr = lbr * xr - lbi * xi + bu[t].x, nxi = lbr * xi + lbi * xr + bu[t].y;
            xr = nxr; xi = nxi;
            if (PASS2) Xs[t * 64 + lane] = pg8::cvt_pk_bf16(xr, xi);
        }
        if (PASS2) {
            pg8::f32x4 y = {0.f, 0.f, 0.f, 0.f};
            y = __builtin_amdgcn_mfma_f32_16x16x32_bf16(a, Df, y, 0, 0, 0);
#pragma unroll
            for (int ks = 0; ks < 4; ++ks) { const pg8::bf16x8 xa = *(const LAS pg8::bf16x8*)((const LAS unsigned short*)Xs + c16 * 128 + 32 * ks + 8 * kq); y = __builtin_amdgcn_mfma_f32_16x16x32_bf16(xa, Cf[ks], y, 0, 0, 0); }
#pragma unroll
            for (int r = 0; r < 4; ++r) { const size_t m = r0 + 4 * kq + r; YG[m * 512 + g * 16 + c16] = (unsigned short)f2bf(gelu_tanh_fast(y[r])); }
        }
    }
}
__device__ __forceinline__ void s5_unit(Frame& F, const Args& A, int b, int g) {
    typedef float f32x2 __attribute__((ext_vector_type(2)));
    const int lane = F.lane, w = F.wave, c16 = lane & 15, kq = lane >> 4;
    const float* log_dt = A.in[4]; const float* lam_re = A.in[5]; const float* lam_im = A.in[6]; const float* b_re = A.in[7]; const float* b_im = A.in[8];
    const float* c_re = A.in[9]; const float* c_im = A.in[10]; const float* d_skip = A.in[11];
    const unsigned short* U = (const unsigned short*)(A.ws + WS_U); unsigned short* YG = (unsigned short*)(A.ws + WS_YG);
    LAS float* BUs = (LAS float*)(F.lds + RING_OFF + w * 12288);
    LAS unsigned* Xs = (LAS unsigned*)(F.lds + RING_OFF + w * 12288 + 8192);
    LAS f32x2* Es = (LAS f32x2*)(F.lds + RING_OFF + 98304);
    const float dt = expf(log_dt[g]);
    float lbr, lbi; s5_lambar(lam_re[g * 64 + lane], lam_im[g * 64 + lane], dt, lbr, lbi);
    pg8::bf16x8 Bf[8], Cf[4];
#pragma unroll
    for (int nb = 0; nb < 8; ++nb) {
        const int comp = 16 * nb + c16, pp = comp >> 1, im = comp & 1;
        const float lr = lam_re[g * 64 + pp], li = lam_im[g * 64 + pp]; float pr, pi; s5_lambar(lr, li, dt, pr, pi);
        const float nr = pr - 1.0f, ni = pi, den = lr * lr + li * li, cr = (nr * lr + ni * li) / den, ci = (ni * lr - nr * li) / den;
#pragma unroll
        for (int j = 0; j < 8; ++j) { float val = 0.f;
            if (kq < 2) { const int h = 8 * kq + j; const float br = b_re[(g * 64 + pp) * 16 + h], bi = b_im[(g * 64 + pp) * 16 + h]; val = im ? (cr * bi + ci * br) : (cr * br - ci * bi); }
            Bf[nb][j] = (short)f2bf(val); }
    }
#pragma unroll
    for (int ks = 0; ks < 4; ++ks)
#pragma unroll
        for (int j = 0; j < 8; ++j) { const int comp = 32 * ks + 8 * kq + j, pp = comp >> 1, im = comp & 1;
            const float val = im ? -c_im[(g * 16 + c16) * 64 + pp] : c_re[(g * 16 + c16) * 64 + pp]; Cf[ks][j] = (short)f2bf(val); }
    pg8::bf16x8 Df;
#pragma unroll
    for (int j = 0; j < 8; ++j) Df[j] = (short)((kq < 2 && 8 * kq + j == c16) ? f2bf(d_skip[g * 16 + c16]) : 0u);
    const size_t row0 = (size_t)b * SEQ + (size_t)w * 512;
    float xr = 0.f, xi = 0.f;
    s5_pass<false>(U, YG, row0, g, BUs, Xs, Bf, Cf, Df, lbr, lbi, xr, xi, lane);
    Es[w * 64 + lane] = (f32x2){xr, xi};
    LDS_WAIT(); __syncthreads();
    float pr = lbr, pi = lbi;
#pragma unroll
    for (int i = 0; i < 9; ++i) { const float t = pr * pr - pi * pi; pi = 2.0f * pr * pi; pr = t; }
    xr = 0.f; xi = 0.f;
    for (int v = 0; v < w; ++v) { const f32x2 e = Es[v * 64 + lane]; const float nr = pr * xr - pi * xi + e.x, ni = pr * xi + pi * xr + e.y; xr = nr; xi = ni; }
    s5_pass<true>(U, YG, row0, g, BUs, Xs, Bf, Cf, Df, lbr, lbi, xr, xi, lane);
    LDS_WAIT(); __syncthreads();
}

typedef float f32x16 __attribute__((ext_vector_type(16)));
constexpr int RT_PITCH = 136;
__device__ __forceinline__ int crow16(int r, int hi) { return (r & 3) + 8 * (r >> 2) + 4 * hi; }
__device__ __forceinline__ float ret_log2gamma(int h) { return log2f(1.0f - exp2f(-5.0f - (float)h)); }
__device__ __forceinline__ pg8::bf16x8 gather8(const LAS unsigned short* p, int o0, int o1, int o2, int o3, int o4, int o5, int o6, int o7) {
    pg8::bf16x8 f; f[0] = (short)p[o0]; f[1] = (short)p[o1]; f[2] = (short)p[o2]; f[3] = (short)p[o3]; f[4] = (short)p[o4]; f[5] = (short)p[o5]; f[6] = (short)p[o6]; f[7] = (short)p[o7]; return f; }

__device__ __forceinline__ void conv_phase(Frame& F, const Args& A) {
    const unsigned short* HC = (const unsigned short*)(A.ws + WS_P1); const unsigned short* GB = HC + P1_STRIDE; const unsigned short* GC = HC + 2 * P1_STRIDE;
    unsigned short* MIX1 = (unsigned short*)(A.ws + WS_MIX1); const float* cw = A.in[17];
    for (int it = F.vcu * (NWAVES * 64) + F.tid; it < (MTOK / 16) * 64; it += F.G * NWAVES * 64) {
        const int cg = it & 63, run = it >> 6, c0 = cg * 8; const size_t m0 = (size_t)run * 16; const int l0 = (int)(m0 & 4095);
        float w0[8], w1[8], w2[8], z1[8], z2[8];
#pragma unroll
        for (int e = 0; e < 8; ++e) { w0[e] = cw[c0 + e]; w1[e] = cw[512 + c0 + e]; w2[e] = cw[1024 + c0 + e]; z1[e] = 0.f; z2[e] = 0.f; }
        if (l0 > 0) {
            const v4u h1 = *(const v4u*)(HC + (m0 - 1) * 512 + c0), g1 = *(const v4u*)(GC + (m0 - 1) * 512 + c0), h2 = *(const v4u*)(HC + (m0 - 2) * 512 + c0), g2 = *(const v4u*)(GC + (m0 - 2) * 512 + c0);
#pragma unroll
            for (int e = 0; e < 4; ++e) { z1[2 * e] = __uint_as_float(h1[e] << 16) * __uint_as_float(g1[e] << 16); z1[2 * e + 1] = __uint_as_float(h1[e] & 0xffff0000u) * __uint_as_float(g1[e] & 0xffff0000u);
                z2[2 * e] = __uint_as_float(h2[e] << 16) * __uint_as_float(g2[e] << 16); z2[2 * e + 1] = __uint_as_float(h2[e] & 0xffff0000u) * __uint_as_float(g2[e] & 0xffff0000u); }
        }
        for (int t = 0; t < 16; ++t) {
            const size_t m = m0 + t;
            const v4u hh = *(const v4u*)(HC + m * 512 + c0), gc = *(const v4u*)(GC + m * 512 + c0), gb = *(const v4u*)(GB + m * 512 + c0);
            float z[8], o[8];
#pragma unroll
            for (int e = 0; e < 4; ++e) { z[2 * e] = __uint_as_float(hh[e] << 16) * __uint_as_float(gc[e] << 16); z[2 * e + 1] = __uint_as_float(hh[e] & 0xffff0000u) * __uint_as_float(gc[e] & 0xffff0000u); }
#pragma unroll
            for (int e = 0; e < 8; ++e) { const float y = w0[e] * z2[e] + w1[e] * z1[e] + w2[e] * z[e]; const float gbv = (e & 1) ? __uint_as_float(gb[e >> 1] & 0xffff0000u) : __uint_as_float(gb[e >> 1] << 16); o[e] = gbv * y; z2[e] = z1[e]; z1[e] = z[e]; }
            v4u ow; ow.x = pk2(o[0], o[1]); ow.y = pk2(o[2], o[3]); ow.z = pk2(o[4], o[5]); ow.w = pk2(o[6], o[7]);
            *(v4u*)(MIX1 + m * 1024 + c0) = ow;
        }
    }
}
__device__ __forceinline__ void ret_stage_tile(Frame& F, const unsigned short* src, size_t t0, int col0, LAS unsigned short* dst, bool decay, float lg) {
#pragma unroll
    for (int i = 0; i < 4; ++i) { const int f = F.tid + 512 * i, row = f >> 4, cq = (f & 15) * 8;
        v4u v = *(const v4u*)(src + (t0 + row) * 512 + col0 + cq);
        if (decay) { const float s = exp2f(lg * (float)(127 - row));
#pragma unroll
            for (int e = 0; e < 4; ++e) v[e] = pk2(__uint_as_float(v[e] << 16) * s, __uint_as_float(v[e] & 0xffff0000u) * s); }
        *(LAS v4u*)(dst + row * RT_PITCH + cq) = v; }
}
__device__ __forceinline__ void ret_kv_unit(Frame& F, const Args& A, int u) {
    const int b = u >> 5, h = (u >> 3) & 3, a = u & 7, lane = F.lane, w = F.wave, l31 = lane & 31, hi = lane >> 5;
    const unsigned short* RK = (const unsigned short*)(A.ws + WS_P1) + 4 * P1_STRIDE; const unsigned short* RV = (const unsigned short*)(A.ws + WS_P1) + 5 * P1_STRIDE;
    float* PT = (float*)(A.ws + WS_KV) + (size_t)u * 4 * 16384;
    LAS unsigned short* Ks = (LAS unsigned short*)(F.lds + RING_OFF); LAS unsigned short* Vs = Ks + 128 * RT_PITCH;
    const float lg = ret_log2gamma(h), g128 = exp2f(lg * 128.0f);
    const int vb = w >> 1, db0 = 2 * (w & 1);
    f32x16 acc[2]; acc[0] = f32x16{}; acc[1] = f32x16{};
    for (int r = 0; r < 4; ++r) {
        const size_t t0 = (size_t)b * SEQ + (size_t)(4 * a + r) * 128;
        __syncthreads();
        ret_stage_tile(F, RK, t0, h * 128, Ks, true, lg); ret_stage_tile(F, RV, t0, h * 128, Vs, false, 0.f);
        LDS_WAIT(); __syncthreads();
        if (r > 0) {
#pragma unroll
            for (int j = 0; j < 2; ++j)
#pragma unroll
                for (int q = 0; q < 16; ++q) PT[(size_t)r * 16384 + (vb * 32 + crow16(q, hi)) * 128 + (db0 + j) * 32 + l31] = acc[j][q];
        }
#pragma unroll
        for (int j = 0; j < 2; ++j) acc[j] = acc[j] * g128;
#pragma unroll
        for (int ks = 0; ks < 8; ++ks) {
            const int tk = 16 * ks + 8 * hi;
            const LAS unsigned short* vp = Vs + tk * RT_PITCH + vb * 32 + l31;
            const pg8::bf16x8 af = gather8(vp, 0, RT_PITCH, 2 * RT_PITCH, 3 * RT_PITCH, 4 * RT_PITCH, 5 * RT_PITCH, 6 * RT_PITCH, 7 * RT_PITCH);
#pragma unroll
            for (int j = 0; j < 2; ++j) { const LAS unsigned short* kp = Ks + tk * RT_PITCH + (db0 + j) * 32 + l31;
                const pg8::bf16x8 bfr = gather8(kp, 0, RT_PITCH, 2 * RT_PITCH, 3 * RT_PITCH, 4 * RT_PITCH, 5 * RT_PITCH, 6 * RT_PITCH, 7 * RT_PITCH);
                acc[j] = __builtin_amdgcn_mfma_f32_32x32x16_bf16(af, bfr, acc[j], 0, 0, 0); }
        }
    }
#pragma unroll
    for (int j = 0; j < 2; ++j)
#pragma unroll
        for (int q = 0; q < 16; ++q) PT[(vb * 32 + crow16(q, hi)) * 128 + (db0 + j) * 32 + l31] = acc[j][q];
    __syncthreads();
}
__device__ __forceinline__ void ret_out_group(Frame& F, const Args& A, int gidx) {
    const int b = gidx >> 5, h = (gidx >> 3) & 3, a = gidx & 7, lane = F.lane, w = F.wave, l31 = lane & 31, hi = lane >> 5;
    const unsigned short* RQ = (const unsigned short*)(A.ws + WS_P1) + 3 * P1_STRIDE; const unsigned short* RK = RQ + P1_STRIDE; const unsigned short* RV = RQ + 2 * P1_STRIDE; const unsigned short* RG = RQ + 3 * P1_STRIDE;
    unsigned short* MIX1 = (unsigned short*)(A.ws + WS_MIX1);
    const float* PTg = (const float*)(A.ws + WS_KV) + (size_t)((b * 4 + h) * 8) * 4 * 16384;
    LAS unsigned short* Ss = (LAS unsigned short*)(F.lds + RING_OFF); LAS unsigned short* Vs = Ss + 128 * RT_PITCH; LAS unsigned short* Ks = Vs + 128 * RT_PITCH; LAS float* GN = (LAS float*)(F.lds + RING_OFF + 3 * 128 * RT_PITCH * 2);
    const float lg = ret_log2gamma(h);
    f32x4 s4[8];
#pragma unroll
    for (int k = 0; k < 8; ++k) s4[k] = (f32x4){0.f, 0.f, 0.f, 0.f};
    for (int ap = 0; ap < a; ++ap) { const float cf = exp2f(lg * 512.0f * (float)(a - 1 - ap)); const f32x4* T = (const f32x4*)(PTg + (size_t)ap * 4 * 16384);
#pragma unroll
        for (int k = 0; k < 8; ++k) s4[k] += T[F.tid + 512 * k] * cf; }
    f32x4* S4A = (f32x4*)(A.ws + WS_S4A) + (size_t)gidx * 4096;
#pragma unroll
    for (int k = 0; k < 8; ++k) S4A[F.tid + 512 * k] = s4[k];
    VM_WAIT(); __syncthreads();
    const int qb = w & 3, vh = w >> 2, qpos = 32 * qb + l31;
    for (int r = 0; r < 4; ++r) {
        const int i = 4 * a + r; const size_t t0 = (size_t)b * SEQ + (size_t)i * 128;
        const float gr = exp2f(lg * 128.0f * (float)r);
        f32x4 pr[8];
        if (r > 0) { const f32x4* P = (const f32x4*)(PTg + (size_t)a * 4 * 16384 + (size_t)r * 16384);
#pragma unroll
            for (int k = 0; k < 8; ++k) pr[k] = S4A[F.tid + 512 * k] * gr + P[F.tid + 512 * k]; }
        else {
#pragma unroll
            for (int k = 0; k < 8; ++k) pr[k] = S4A[F.tid + 512 * k]; }
        __syncthreads();
#pragma unroll
        for (int k = 0; k < 8; ++k) { const int e = 4 * (F.tid + 512 * k); const f32x4 v = pr[k];
            pg8::u32x2 o; o.x = pk2(v[0], v[1]); o.y = pk2(v[2], v[3]); *(LAS pg8::u32x2*)(Ss + (e >> 7) * RT_PITCH + (e & 127)) = o; }
        ret_stage_tile(F, RV, t0, h * 128, Vs, false, 0.f); ret_stage_tile(F, RK, t0, h * 128, Ks, false, 0.f);
        pg8::bf16x8 qf[8];
#pragma unroll
        for (int ks = 0; ks < 8; ++ks) qf[ks] = *(const pg8::bf16x8*)(RQ + (t0 + 32 * qb + l31) * 512 + h * 128 + 16 * ks + 8 * hi);
        LDS_WAIT(); __syncthreads();
        f32x16 inner[2], cross[2]; inner[0] = f32x16{}; inner[1] = f32x16{}; cross[0] = f32x16{}; cross[1] = f32x16{};
        for (int sb = 0; sb <= qb; ++sb) {
            f32x16 st = f32x16{};
#pragma unroll
            for (int ks = 0; ks < 8; ++ks) { const pg8::bf16x8 kf = *(const LAS pg8::bf16x8*)(Ks + (32 * sb + l31) * RT_PITCH + 16 * ks + 8 * hi); st = __builtin_amdgcn_mfma_f32_32x32x16_bf16(kf, qf[ks], st, 0, 0, 0); }
#pragma unroll
            for (int q = 0; q < 16; ++q) { const int sp = 32 * sb + crow16(q, hi); const int dlt = qpos - sp; st[q] = (dlt >= 0) ? st[q] * exp2f(lg * (float)dlt) : 0.f; }
#pragma unroll
            for (int s2 = 0; s2 < 2; ++s2) {
                pg8::bf16x8 af; { const unsigned a0 = pg8::cvt_pk_bf16(st[8 * s2], st[8 * s2 + 1]), a1 = pg8::cvt_pk_bf16(st[8 * s2 + 2], st[8 * s2 + 3]), a2 = pg8::cvt_pk_bf16(st[8 * s2 + 4], st[8 * s2 + 5]), a3 = pg8::cvt_pk_bf16(st[8 * s2 + 6], st[8 * s2 + 7]);
                    const pg8::u32x4 aw = {a0, a1, a2, a3}; af = __builtin_bit_cast(pg8::bf16x8, aw); }
                const int srow = 32 * sb + 16 * s2 + 4 * hi;
#pragma unroll
                for (int j = 0; j < 2; ++j) { const LAS unsigned short* vp = Vs + srow * RT_PITCH + vh * 64 + j * 32 + l31;
                    const pg8::bf16x8 bfr = gather8(vp, 0, RT_PITCH, 2 * RT_PITCH, 3 * RT_PITCH, 8 * RT_PITCH, 9 * RT_PITCH, 10 * RT_PITCH, 11 * RT_PITCH);
                    inner[j] = __builtin_amdgcn_mfma_f32_32x32x16_bf16(bfr, af, inner[j], 0, 0, 0); }
            }
        }
#pragma unroll
        for (int ks = 0; ks < 8; ++ks)
#pragma unroll
            for (int j = 0; j < 2; ++j) { const pg8::bf16x8 sf = *(const LAS pg8::bf16x8*)(Ss + (vh * 64 + j * 32 + l31) * RT_PITCH + 16 * ks + 8 * hi); cross[j] = __builtin_amdgcn_mfma_f32_32x32x16_bf16(sf, qf[ks], cross[j], 0, 0, 0); }
        const size_t mrow = t0 + 32 * qb + l31;
        const unsigned short* rgp = RG + mrow * 512 + h * 128 + vh * 64 + 4 * hi;
        unsigned short* mxp = MIX1 + mrow * 1024 + 512 + h * 128 + vh * 64 + 4 * hi;
        pg8::u32x2 gw[2][4];
#pragma unroll
        for (int j = 0; j < 2; ++j)
#pragma unroll
            for (int g4 = 0; g4 < 4; ++g4) gw[j][g4] = *(const pg8::u32x2*)(rgp + j * 32 + 8 * g4);
        const float qd = exp2f(lg * (float)(qpos + 1));
        float s = 0.f, q2 = 0.f;
#pragma unroll
        for (int j = 0; j < 2; ++j)
#pragma unroll
            for (int e = 0; e < 16; ++e) { const float o = inner[j][e] + qd * cross[j][e]; inner[j][e] = o; s += o; q2 += o * o; }
        { auto r0_ = __builtin_amdgcn_permlane32_swap(__float_as_uint(s), __float_as_uint(s), false, false); s = __uint_as_float(r0_[0]) + __uint_as_float(r0_[1]);
          auto r1_ = __builtin_amdgcn_permlane32_swap(__float_as_uint(q2), __float_as_uint(q2), false, false); q2 = __uint_as_float(r1_[0]) + __uint_as_float(r1_[1]); }
        if (hi == 0) { GN[(qpos * 2 + vh) * 2] = s; GN[(qpos * 2 + vh) * 2 + 1] = q2; }
        LDS_WAIT(); __syncthreads();
        { const float sa = GN[qpos * 4] + GN[qpos * 4 + 2], qa = GN[qpos * 4 + 1] + GN[qpos * 4 + 3];
          const float mu = sa * (1.0f / 128.0f), var = fmaxf(qa * (1.0f / 128.0f) - mu * mu, 0.f), rs = __builtin_amdgcn_rsqf(var + 1e-6f);
#pragma unroll
          for (int j = 0; j < 2; ++j)
#pragma unroll
            for (int g4 = 0; g4 < 4; ++g4) { float o[4];
#pragma unroll
                for (int e = 0; e < 4; ++e) { const unsigned wv = gw[j][g4][e >> 1]; const float gv = (e & 1) ? __uint_as_float(wv & 0xffff0000u) : __uint_as_float(wv << 16);
                    o[e] = gv * __builtin_amdgcn_rcpf(1.0f + __expf(-gv)) * (inner[j][4 * g4 + e] - mu) * rs; }
                pg8::u32x2 ow; ow.x = pg8::cvt_pk_bf16(o[0], o[1]); ow.y = pg8::cvt_pk_bf16(o[2], o[3]);
                *(pg8::u32x2*)(mxp + j * 32 + 8 * g4) = ow; } }
    }
    __syncthreads();
}
#ifndef REP_MASK
#define REP_MASK 0
#endif
#define NREP(k) ((((REP_MASK) >> (k)) & 1) ? 2 : 1)
__global__ void __launch_bounds__(NWAVES * 64, 2) mk_fwd(Args args) {
    extern __shared__ __attribute__((aligned(16))) unsigned char lds[];
    Frame F;
    F.lds = (LAS unsigned char*)lds;
    F.MISC = (volatile LAS unsigned*)(F.lds + MISC_OFF);
    F.tid = threadIdx.x; F.lane = F.tid & 63; F.wave = __builtin_amdgcn_readfirstlane(F.tid >> 6);
    F.G = gridDim.x; { const int bx = blockIdx.x; F.vcu = (F.G % 8 == 0) ? (bx % 8) * (F.G / 8) + bx / 8 : bx; }
    unsigned char* ws = args.ws;
    F.ctl = (gu32*)(ws + WS_CTL);
    for (int u = F.tid; u < (LDS_BYTES - LDSCTL_OFF) / 4; u += NWAVES * 64) ((LAS unsigned*)(F.lds + LDSCTL_OFF))[u] = 0u;
    __syncthreads();
    const int lo = args.ph_lo, hi = args.ph_hi;
    const bool single = (hi - lo) > 1;
    XcdBarrier bar; bar.bar = (unsigned*)(F.ctl + CW_BAR) + args.li * XCD_BAR_WORDS; bar.x = 0; bar.st = nullptr;
    if (single) bar = xcd_barrier_post((unsigned*)(F.ctl + CW_BAR) + args.li * XCD_BAR_WORDS, F.MISC + 8);
#ifndef STAG_TICKS
#define STAG_TICKS 150
#endif
#define STAGGER() do { const unsigned long long t0_ = __builtin_amdgcn_s_memrealtime(); const unsigned long long d_ = (unsigned long long)(((blockIdx.x >> 3) & 7) * STAG_TICKS); \
    while (__builtin_amdgcn_s_memrealtime() - t0_ < d_) __builtin_amdgcn_s_sleep(8); } while (0)
#define IN(k) (lo <= (k) && (k) < hi)
#define BOTH(k) (IN(k) && IN((k) + 1))
#define GRID_BAR() xcd_barrier(bar)
    pg8::bf16_t* XB = (pg8::bf16_t*)(ws + WS_XB);
    float* SSP = (float*)(ws + WS_SSP);
    const float* ROT = (const float*)(ws + WS_ROT);

    if (IN(0)) { for (int rp = 0; rp < NREP(0); ++rp) { p0_prologue(F, args); LDS_WAIT(); __syncthreads(); } if (BOTH(0)) GRID_BAR(); }

    if (IN(1)) {
        if (blockIdx.x < 64) p1_cumsum(F, args, (int)blockIdx.x);
        pg8::Gemm g{XB, (const pg8::bf16_t*)(ws + WS_WIN0), MTOK, 2048, DM}; pg8::StaticOrder S; S.init(MTOK, 2048, F.G, (int)blockIdx.x);
        pg8::EpiRsBf16<0, false, true> E{(pg8::bf16_t*)(ws + WS_Q), 512, 2, (size_t)(16 * MiB), SSP, 1, nullptr, 0, 0, (unsigned*)(F.ctl + CW_NRM)};
        for (int rp = 0; rp < NREP(1); ++rp) pg8::gemm_phase<pg8::EpiRsBf16<0, false, true>, pg8::StaticOrder, true, true>(F.lds + RING_OFF, g, S, E);
        if (BOTH(1)) GRID_BAR();
    }
    if (IN(2)) {
        for (int rp = 0; rp < NREP(2); ++rp) for (int u = F.vcu; u < 256; u += F.G) s5_unit(F, args, u >> 5, u & 31);
        const attn_body::AttnTensors AT{(const attn_body::bf16*)(ws + WS_Q), (const attn_body::bf16*)(ws + WS_K), (const attn_body::bf16*)(ws + WS_V), (attn_body::bf16*)(ws + WS_MIX), (const float*)(ws + WS_CB), (const unsigned*)(F.ctl + CW_NRM)};
        const attn_body::StaticOrder S((int)F.G, (int)blockIdx.x);
        for (int rp = 0; rp < NREP(14); ++rp) attn_body::attn_phase<attn_body::StaticOrder>((char*)lds + RING_OFF, AT, S);
        if (BOTH(2)) GRID_BAR();
    }
    if (IN(3)) {
        pg8::Gemm g{(const pg8::bf16_t*)(ws + WS_YG), (const pg8::bf16_t*)(ws + WS_WGLU), MTOK, 512, 512}; pg8::StaticOrder S; S.init(MTOK, 512, F.G, (int)blockIdx.x);
        pg8::EpiGlu E{(const pg8::bf16_t*)(ws + WS_YG), 512, args.in[13], (pg8::bf16_t*)(ws + WS_MIX), 1024, 512};
        for (int rp = 0; rp < NREP(3); ++rp) pg8::gemm_phase<pg8::EpiGlu, pg8::StaticOrder, true, true>(F.lds + RING_OFF, g, S, E);
        if (BOTH(3)) GRID_BAR();
    }
    if (IN(4)) {
        pg8::Gemm g{(const pg8::bf16_t*)(ws + WS_MIX), (const pg8::bf16_t*)(ws + WS_WOUT0), MTOK, DM, DM}; pg8::StaticOrder S; S.init(MTOK, DM, F.G, (int)blockIdx.x);
        pg8::EpiResid<false> E{args.in[0], nullptr, XB, SSP, DM};
        for (int rp = 0; rp < NREP(4); ++rp) pg8::gemm_phase<pg8::EpiResid<false>, pg8::StaticOrder, true, true>(F.lds + RING_OFF, g, S, E);
        if (BOTH(4)) GRID_BAR();
    }
    if (IN(5)) {
        pg8::Gemm g{XB, (const pg8::bf16_t*)(ws + WS_WUP0), MTOK, DFF, DM}; pg8::StaticOrder S; S.init(MTOK, DFF, F.G, (int)blockIdx.x);
        pg8::EpiRsBf16<1, false> E{(pg8::bf16_t*)(ws + WS_BIG), DFF, 0, 0, SSP, 16, nullptr, 0, 0, nullptr};
        for (int rp = 0; rp < NREP(5); ++rp) pg8::gemm_phase<pg8::EpiRsBf16<1, false>, pg8::StaticOrder, true, true>(F.lds + RING_OFF, g, S, E);
        if (BOTH(5)) GRID_BAR();
    }
    if (IN(6)) {
        pg8::Gemm g{(const pg8::bf16_t*)(ws + WS_BIG), (const pg8::bf16_t*)(ws + WS_WDN0), MTOK, DM, DFF}; pg8::StaticOrder S; S.init(MTOK, DM, F.G, (int)blockIdx.x);
        pg8::EpiResid<true> E{nullptr, XB, XB, SSP, DM};
        pg8::gemm_phase<pg8::EpiResid<true>, pg8::StaticOrder, true, true>(F.lds + RING_OFF, g, S, E);
        if (BOTH(6)) GRID_BAR();
    }
    if (IN(7)) {
        pg8::Gemm g{XB, (const pg8::bf16_t*)(ws + WS_WIN1), MTOK, 3584, DM}; pg8::StaticOrder S; S.init(MTOK, 3584, F.G, (int)blockIdx.x);
        pg8::EpiRsBf16<0, true> E{(pg8::bf16_t*)(ws + WS_P1), 512, 2, (size_t)(16 * MiB), SSP, 16, ROT, 6, 10, nullptr};
        for (int rp = 0; rp < NREP(7); ++rp) pg8::gemm_phase<pg8::EpiRsBf16<0, true>, pg8::StaticOrder, true, true>(F.lds + RING_OFF, g, S, E);
        if (BOTH(7)) GRID_BAR();
    }
    if (IN(8)) {
        for (int rp = 0; rp < NREP(8); ++rp) conv_phase(F, args);
        for (int rp = 0; rp < NREP(15); ++rp) for (int u = F.vcu; u < 256; u += F.G) ret_kv_unit(F, args, u);
        if (BOTH(8)) GRID_BAR();
    }
    if (IN(9)) {
        for (int rp = 0; rp < NREP(9); ++rp) for (int u = F.vcu; u < 256; u += F.G) ret_out_group(F, args, u);
        if (BOTH(9)) GRID_BAR();
    }
    if (IN(10)) {
        pg8::Gemm g{(const pg8::bf16_t*)(ws + WS_MIX1), (const pg8::bf16_t*)(ws + WS_WOUT1), MTOK, DM, DM}; pg8::StaticOrder S; S.init(MTOK, DM, F.G, (int)blockIdx.x);
        pg8::EpiResid<true> E{nullptr, XB, XB, SSP, DM};
        pg8::gemm_phase<pg8::EpiResid<true>, pg8::StaticOrder, true, true>(F.lds + RING_OFF, g, S, E);
        if (BOTH(10)) GRID_BAR();
    }
    if (IN(11)) {
        pg8::Gemm g{XB, (const pg8::bf16_t*)(ws + WS_WUP1), MTOK, DFF, DM}; pg8::StaticOrder S; S.init(MTOK, DFF, F.G, (int)blockIdx.x);
        pg8::EpiRsBf16<1, false> E{(pg8::bf16_t*)(ws + WS_BIG), DFF, 0, 0, SSP, 16, nullptr, 0, 0, nullptr};
        pg8::gemm_phase<pg8::EpiRsBf16<1, false>, pg8::StaticOrder, true, true>(F.lds + RING_OFF, g, S, E);
        if (BOTH(11)) GRID_BAR();
    }
    if (IN(12)) {
        pg8::Gemm g{(const pg8::bf16_t*)(ws + WS_BIG), (const pg8::bf16_t*)(ws + WS_WDN1), MTOK, DM, DFF}; pg8::StaticOrder S; S.init(MTOK, DM, F.G, (int)blockIdx.x);
        pg8::EpiResid<true> E{nullptr, XB, XB, SSP, DM};
        pg8::gemm_phase<pg8::EpiResid<true>, pg8::StaticOrder, true, true>(F.lds + RING_OFF, g, S, E);
        if (BOTH(12)) GRID_BAR();
    }
    if (IN(13)) p_final(F, args);
#undef IN
#undef BOTH
#undef GRID_BAR
}
extern "C" void kernel_launch(void* const* d_in, const int* in_sizes, int n_in, void* d_out, int out_size, void* d_ws, size_t ws_size, hipStream_t stream) {
    static int grid = 0;
    if (grid == 0) {
        if (n_in != 23 || out_size != MTOK * DM || ws_size < WS_END) { fprintf(stderr, "kernel_launch: unexpected problem: n_in %d out %d ws %zu\n", n_in, out_size, ws_size); grid = -1; return; }
        int dev = 0, cus = 0;
        if (hipGetDevice(&dev) != hipSuccess || hipDeviceGetAttribute(&cus, hipDeviceAttributeMultiprocessorCount, dev) != hipSuccess) { grid = -1; return; }
        if (hipFuncSetAttribute((const void*)mk_fwd, hipFuncAttributeMaxDynamicSharedMemorySize, LDS_BYTES) != hipSuccess) { fprintf(stderr, "kernel_launch: hipFuncSetAttribute failed\n"); grid = -1; return; }
        (void)hipGetLastError();
        grid = cus;
    }
    if (grid < 0) return;
    (void)hipMemsetAsync((char*)d_ws + WS_CTL, 0, CTL_ZERO_BYTES, stream);
    Args a{};
    for (int i = 0; i < 23; ++i) a.in[i] = (const float*)d_in[i];
    a.out = (float*)d_out; a.ws = (unsigned char*)d_ws;
    unsigned char* ws = (unsigned char*)d_ws;
    int nl = 0;
    auto run = [&](int lo, int hi) { a.ph_lo = lo; a.ph_hi = hi; a.li = nl++; hipLaunchKernelGGL(mk_fwd, dim3(grid), dim3(NWAVES * 64), LDS_BYTES, stream, a); };
    typedef unsigned short b16;
    run(0, 14);
}
```
